# Optimizing an MI355X kernel written in HIP

```python
import math
import jax, jax.numpy as jnp
from jax import lax
import numpy as np

D_MODEL = 1024
BATCH = 8
SEQ = 4096
DEPTH = 2

HEAD_DIM = 64
MOBA_HEADS = D_MODEL // 128
MOBA_WIDTH = MOBA_HEADS * HEAD_DIM
DIFF_HEADS = D_MODEL // 256
DIFF_QK_WIDTH = DIFF_HEADS * 2 * HEAD_DIM
DIFF_VDIM = 2 * HEAD_DIM
DIFF_WIDTH = DIFF_HEADS * DIFF_VDIM
MIX_WIDTH = MOBA_WIDTH + DIFF_WIDTH
IN_WIDTH = 4 * MOBA_WIDTH + 2 * DIFF_QK_WIDTH + 2 * DIFF_WIDTH
MOBA_BLOCK = 256
MOBA_TOPK = 3
MOBA_QCHUNK = 32
DIFF_QBLOCK = 128
NORM_EPS = 1e-6
NEG_INF = -1e30

kernel_name = "hymba_moba_diffattn_alibi_block"


def rms_norm(x, g):
    xf = x.astype(jnp.float32)
    y = xf * lax.rsqrt(jnp.mean(xf * xf, axis=-1, keepdims=True) + NORM_EPS)
    return (y * g.astype(jnp.float32)).astype(x.dtype)


def alibi_slopes(n_heads):
    return jnp.asarray(2.0 ** (-8.0 * np.arange(1, n_heads + 1) / n_heads), dtype=jnp.float32)


def moba_attention(q, k, v, slopes):
    B, H, S, dh = q.shape
    nb = S // MOBA_BLOCK
    kb = k.reshape(B, H, nb, MOBA_BLOCK, dh)
    vb = v.reshape(B, H, nb, MOBA_BLOCK, dh)
    scale = dh ** -0.5
    topk = min(MOBA_TOPK, nb - 1)
    q_blk = jnp.arange(S) // MOBA_BLOCK
    if topk > 0:
        k_mean = jnp.mean(kb.astype(jnp.float32), axis=3)
        gate = jnp.einsum('bhsd,bhnd->bhsn', q.astype(jnp.float32), k_mean)
        past = jnp.arange(nb)[None, :] < q_blk[:, None]
        gate = jnp.where(past[None, None], gate, NEG_INF)
        _, sel_idx = lax.top_k(gate, topk)
    bi = jnp.arange(B)[:, None, None, None]
    hi = jnp.arange(H)[None, :, None, None]
    slope4 = slopes[None, :, None, None]

    def chunk(c):
        t0 = c * MOBA_QCHUNK
        qc = lax.dynamic_slice_in_dim(q, t0, MOBA_QCHUNK, axis=2)
        tq = t0 + jnp.arange(MOBA_QCHUNK)
        own = t0 // MOBA_BLOCK
        k_own = lax.dynamic_index_in_dim(kb, own, axis=2, keepdims=False)
        v_own = lax.dynamic_index_in_dim(vb, own, axis=2, keepdims=False)
        s_own = own * MOBA_BLOCK + jnp.arange(MOBA_BLOCK)
        dist_own = (tq[:, None] - s_own[None, :]).astype(jnp.float32)
        sc_own = jnp.einsum('bhqd,bhkd->bhqk', qc, k_own).astype(jnp.float32) * scale - slope4 * dist_own
        sc_own = jnp.where((s_own[None, :] <= tq[:, None])[None, None], sc_own, NEG_INF)
        if topk == 0:
            p = jax.nn.softmax(sc_own, axis=-1)
            return jnp.einsum('bhqk,bhkd->bhqd', p.astype(v.dtype), v_own)
        ic = lax.dynamic_slice_in_dim(sel_idx, t0, MOBA_QCHUNK, axis=2)
        k_sel = kb[bi, hi, ic]
        v_sel = vb[bi, hi, ic]
        s_sel = ic[..., None] * MOBA_BLOCK + jnp.arange(MOBA_BLOCK)
        dist_sel = (tq[None, None, :, None, None] - s_sel).astype(jnp.float32)
        sc_sel = jnp.einsum('bhqd,bhqjkd->bhqjk', qc, k_sel).astype(jnp.float32) * scale
        sc_sel = sc_sel - slopes[None, :, None, None, None] * dist_sel
        sc_sel = jnp.where((ic < own)[..., None], sc_sel, NEG_INF)
        n_sel = topk * MOBA_BLOCK
        scores = jnp.concatenate([sc_sel.reshape(B, H, MOBA_QCHUNK, n_sel), sc_own], axis=-1)
        p = jax.nn.softmax(scores, axis=-1).astype(v.dtype)
        out = jnp.einsum('bhqk,bhqkd->bhqd', p[..., :n_sel],
                         v_sel.reshape(B, H, MOBA_QCHUNK, n_sel, dh))
        return out + jnp.einsum('bhqk,bhkd->bhqd', p[..., n_sel:], v_own)

    outs = lax.map(chunk, jnp.arange(S // MOBA_QCHUNK))
    return outs.transpose(1, 2, 0, 3, 4).reshape(B, H, S, dh)


def diff_attention(q, k, v, lam, slopes):
    B, H, S, _, dh = q.shape
    scale = dh ** -0.5
    sk = jnp.arange(S)
    slope5 = slopes[None, :, None, None, None]

    def block(c):
        t0 = c * DIFF_QBLOCK
        qc = lax.dynamic_slice_in_dim(q, t0, DIFF_QBLOCK, axis=2)
        tq = t0 + jnp.arange(DIFF_QBLOCK)
        sc = jnp.einsum('bhqcd,bhkcd->bhcqk', qc, k).astype(jnp.float32) * scale
        dist = (tq[:, None] - sk[None, :]).astype(jnp.float32)
        sc = jnp.where((sk[None, :] <= tq[:, None])[None, None, None], sc - slope5 * dist, NEG_INF)
        p = jax.nn.softmax(sc, axis=-1)
        a = p[:, :, 0] - lam * p[:, :, 1]
        return jnp.einsum('bhqk,bhkd->bhqd', a.astype(v.dtype), v)

    outs = lax.map(block, jnp.arange(S // DIFF_QBLOCK))
    return outs.transpose(1, 2, 0, 3, 4).reshape(B, H, S, v.shape[-1])


def setup_inputs(seed: int = 0) -> dict:
    key = jax.random.key(seed)
    ks = jax.random.split(key, 13)
    f32 = jnp.float32
    nrm = lambda k, shape: jax.random.normal(k, shape, dtype=f32)
    return {
        "x": nrm(ks[0], (BATCH, SEQ, D_MODEL)),
        "norm_g": 1.0 + 0.02 * nrm(ks[1], (DEPTH, D_MODEL)),
        "w_in": nrm(ks[2], (DEPTH, D_MODEL, IN_WIDTH)) * D_MODEL ** -0.5,
        "moba_q_norm": 1.0 + 0.02 * nrm(ks[3], (DEPTH, HEAD_DIM)),
        "moba_k_norm": 1.0 + 0.02 * nrm(ks[4], (DEPTH, HEAD_DIM)),
        "diff_q_norm": 1.0 + 0.02 * nrm(ks[5], (DEPTH, HEAD_DIM)),
        "diff_k_norm": 1.0 + 0.02 * nrm(ks[6], (DEPTH, HEAD_DIM)),
        "lambda_q1": 0.1 * nrm(ks[7], (DEPTH, HEAD_DIM)),
        "lambda_k1": 0.1 * nrm(ks[8], (DEPTH, HEAD_DIM)),
        "lambda_q2": 0.1 * nrm(ks[9], (DEPTH, HEAD_DIM)),
        "lambda_k2": 0.1 * nrm(ks[10], (DEPTH, HEAD_DIM)),
        "diff_subln": 1.0 + 0.02 * nrm(ks[11], (DEPTH, DIFF_VDIM)),
        "w_out": nrm(ks[12], (DEPTH, MIX_WIDTH, D_MODEL)) * MIX_WIDTH ** -0.5,
    }


def reference(x, norm_g, w_in, moba_q_norm, moba_k_norm, diff_q_norm, diff_k_norm,
              lambda_q1, lambda_k1, lambda_q2, lambda_k2, diff_subln, w_out):
    B, S, _ = x.shape
    s_pad = -(-S // MOBA_BLOCK) * MOBA_BLOCK
    moba_slopes = alibi_slopes(MOBA_HEADS)
    diff_slopes = alibi_slopes(DIFF_HEADS)
    split_at = list(np.cumsum([MOBA_WIDTH] * 4 + [DIFF_QK_WIDTH, DIFF_QK_WIDTH, DIFF_WIDTH]))
    for layer in range(DEPTH):
        h = rms_norm(x, norm_g[layer])
        proj = jnp.einsum('bsd,de->bse', h, w_in[layer])
        proj = jnp.pad(proj, ((0, 0), (0, s_pad - S), (0, 0)))
        mq, mk, mv, mg, dq, dk, dv, dg = jnp.split(proj, split_at, axis=-1)

        to_heads = lambda t: t.reshape(B, s_pad, MOBA_HEADS, HEAD_DIM).transpose(0, 2, 1, 3)
        mq = rms_norm(to_heads(mq), moba_q_norm[layer])
        mk = rms_norm(to_heads(mk), moba_k_norm[layer])
        m_out = moba_attention(mq, mk, to_heads(mv), moba_slopes)
        m_out = m_out.transpose(0, 2, 1, 3).reshape(B, s_pad, MOBA_WIDTH) * jax.nn.silu(mg)

        dq = rms_norm(dq.reshape(B, s_pad, DIFF_HEADS, 2, HEAD_DIM).transpose(0, 2, 1, 3, 4), diff_q_norm[layer])
        dk = rms_norm(dk.reshape(B, s_pad, DIFF_HEADS, 2, HEAD_DIM).transpose(0, 2, 1, 3, 4), diff_k_norm[layer])
        dv = dv.reshape(B, s_pad, DIFF_HEADS, DIFF_VDIM).transpose(0, 2, 1, 3)
        lambda_init = 0.8 - 0.6 * math.exp(-0.3 * layer)
        lam = (jnp.exp(jnp.sum(lambda_q1[layer] * lambda_k1[layer]))
               - jnp.exp(jnp.sum(lambda_q2[layer] * lambda_k2[layer])) + lambda_init)
        d_out = diff_attention(dq, dk, dv, lam, diff_slopes)
        d_out = rms_norm(d_out, diff_subln[layer]) * (1.0 - lambda_init)
        d_out = d_out.transpose(0, 2, 1, 3).reshape(B, s_pad, DIFF_WIDTH) * jax.nn.silu(dg)

        mixed = jnp.concatenate([m_out, d_out], axis=-1)[:, :S]
        x = x + jnp.einsum('bse,ed->bsd', mixed, w_out[layer])
    return x
```

```cpp
#include <hip/hip_runtime.h>
#include <cstdio>
#include <cstdint>
namespace pg8 {
#define PG8_LAS __attribute__((address_space(3)))
typedef unsigned short bf16_t;
typedef short bf16x8 __attribute__((ext_vector_type(8)));
typedef float f32x4 __attribute__((ext_vector_type(4)));
typedef unsigned u32x4 __attribute__((ext_vector_type(4)));
constexpr int BM = 256, BK = 64, HALF = 128, HTB = HALF * BK * 2  , STAGE_BYTES = 8 * HTB, NXCD = 8, WGM = 8;

__host__ __device__ __forceinline__ int lds_byte(int r, int c) { const int st = (r >> 4) * 2 + (c >> 5), rr = r & 15, cc = c & 31, ob = rr * 64 + cc * 2; return st * 1024 + (ob ^ (((ob >> 9) & 1) << 5)); }
__host__ __device__ __forceinline__ void stage_rc(int b, int& R, int& C) { const int st = b / 1024, sb = b % 1024, swz = sb ^ (((sb >> 9) & 1) << 5); R = (st >> 1) * 16 + swz / 64; C = (st & 1) * 32 + (swz % 64) / 2; }
__host__ __device__ __forceinline__ int perm32(int rho) { const int n = rho >> 4, i = rho & 15; return 8 * (i >> 2) + 4 * n + (i & 3); }

struct Unit { int pm, pn; };
struct Gemm { const bf16_t* A; const bf16_t* Bt; int M, N, K; };

struct StaticOrder {
    int nM, nN, nwg, G, c;
    __host__ __device__ void init(int M, int N, int G_, int c_) { nM = M / BM; nN = N / BM; nwg = nM * nN; G = G_; c = c_; }
    __host__ __device__ bool next(int i, Unit& u) const {
        const long L = (long)i * G + c; if (L >= nwg) return false;
        int wgid = (int)L; { const int q = nwg / NXCD, r = nwg % NXCD, xcd = wgid % NXCD, off = wgid / NXCD; wgid = (xcd < r ? xcd * (q + 1) : r * (q + 1) + (xcd - r) * q) + off; }
        const int nig = WGM * nN, gid = wgid / nig, fm = gid * WGM, gsz = (nM - fm) < WGM ? (nM - fm) : WGM;
        u.pm = fm + ((wgid % nig) % gsz); u.pn = (wgid % nig) / gsz; return true;
    }
    __device__ __forceinline__ void a_ready(const Unit&) const {}
    __device__ __forceinline__ void done(const Unit&) const {}
};

__device__ __forceinline__ unsigned cvt_pk_bf16(float lo, float hi) { unsigned r; asm volatile("v_cvt_pk_bf16_f32 %0, %1, %2" : "=v"(r) : "v"(lo), "v"(hi)); return r; }
typedef float f32x2 __attribute__((ext_vector_type(2)));
constexpr int PM_ROWS = 32768;
constexpr float C2Q = 0.125f * 1.4426950408889634f;
struct EpiProj {
    static constexpr bool PERM = true, AFTER_DRAIN = false;
    bf16_t* proj;
    const float* ssq;
    const float* normw;
    float* kmean;
    __device__ __forceinline__ void operator()(const f32x4 (&acc)[2][2][4][2], const Unit& u, int wr, int wc, int fr, int fq) const {
        const int mode = u.pn >> 1;
        bf16_t* base = proj + (size_t)mode * PM_ROWS * 512;
        const int col0 = (u.pn & 1) * 256 + wc * 64 + 8 * fq;
        const int row0 = u.pm * BM + wr * 64 + fr;
        const bool isqk = (mode & 2) == 0, isg = (mode & 3) == 3, iskm = (mode == 1);
        f32x4 wv[2][2];
        if (isqk) {
            const float* w = normw + (((mode >> 2) * 2 + (mode & 1)) * 64);
            const float sc = (mode & 1) ? 1.0f : C2Q;
#pragma unroll
            for (int bj = 0; bj < 2; ++bj)
#pragma unroll
                for (int n = 0; n < 2; ++n) wv[bj][n] = *(const f32x4*)(w + 32 * bj + 8 * fq + 4 * n) * sc;
        }
        float rinv[8];
#pragma unroll
        for (int q = 0; q < 8; ++q) {
            const int row = row0 + (q >> 2) * HALF + (q & 3) * 16;
            const f32x4 s0 = *(const f32x4*)(ssq + (size_t)row * 16 + 4 * fq);
            float tot = (s0[0] + s0[1]) + (s0[2] + s0[3]);
            tot += __shfl_xor(tot, 16); tot += __shfl_xor(tot, 32);
            rinv[q] = __builtin_amdgcn_rsqf(tot * (1.0f / 1024.0f) + 1e-6f);
        }
        f32x4 ks[2][2];
#pragma unroll
        for (int bj = 0; bj < 2; ++bj)
#pragma unroll
            for (int n = 0; n < 2; ++n) ks[bj][n] = (f32x4){0.f, 0.f, 0.f, 0.f};
#pragma unroll
        for (int ai = 0; ai < 2; ++ai)
#pragma unroll
            for (int m = 0; m < 4; ++m) {
                const int row = row0 + ai * HALF + m * 16;
                f32x4 v[2][2];
#pragma unroll
                for (int bj = 0; bj < 2; ++bj)
#pragma unroll
                    for (int n = 0; n < 2; ++n) v[bj][n] = acc[ai][bj][m][n] * rinv[ai * 4 + m];
                if (isqk) {
                    float ss = 0.f;
#pragma unroll
                    for (int bj = 0; bj < 2; ++bj)
#pragma unroll
                        for (int n = 0; n < 2; ++n) ss += (v[bj][n][0] * v[bj][n][0] + v[bj][n][1] * v[bj][n][1]) + (v[bj][n][2] * v[bj][n][2] + v[bj][n][3] * v[bj][n][3]);
                    ss += __shfl_xor(ss, 16); ss += __shfl_xor(ss, 32);
                    const float hr = __builtin_amdgcn_rsqf(ss * (1.0f / 64.0f) + 1e-6f);
#pragma unroll
                    for (int bj = 0; bj < 2; ++bj)
#pragma unroll
                        for (int n = 0; n < 2; ++n) { v[bj][n] = v[bj][n] * hr * wv[bj][n]; if (iskm) ks[bj][n] += v[bj][n]; }
                } else if (isg) {
#pragma unroll
                    for (int bj = 0; bj < 2; ++bj)
#pragma unroll
                        for (int n = 0; n < 2; ++n)
#pragma unroll
                            for (int j = 0; j < 4; ++j) { const float x = v[bj][n][j]; v[bj][n][j] = x * __builtin_amdgcn_rcpf(1.0f + __builtin_amdgcn_exp2f(-1.4426950408889634f * x)); }
                }
                bf16_t* rowp = base + (size_t)row * 512 + col0;
#pragma unroll
                for (int bj = 0; bj < 2; ++bj) { u32x4 w4; w4.x = cvt_pk_bf16(v[bj][0][0], v[bj][0][1]); w4.y = cvt_pk_bf16(v[bj][0][2], v[bj][0][3]); w4.z = cvt_pk_bf16(v[bj][1][0], v[bj][1][1]); w4.w = cvt_pk_bf16(v[bj][1][2], v[bj][1][3]);
                    *(u32x4*)(rowp + 32 * bj) = w4; }
                asm volatile("" ::: "memory");
            }
        if (iskm) {
#pragma unroll
            for (int bj = 0; bj < 2; ++bj)
#pragma unroll
                for (int n = 0; n < 2; ++n)
#pragma unroll
                    for (int j = 0; j < 4; ++j) { float x = ks[bj][n][j]; x += __shfl_xor(x, 1); x += __shfl_xor(x, 2); x += __shfl_xor(x, 4); x += __shfl_xor(x, 8); ks[bj][n][j] = x; }
            if (fr == 0) {
                const int b = u.pm >> 4, blk = u.pm & 15, h = (u.pn & 1) * 4 + wc;
                float* kp = kmean + ((size_t)((b * 8 + h) * 16 + blk) * 2 + wr) * 64 + 8 * fq;
#pragma unroll
                for (int bj = 0; bj < 2; ++bj)
#pragma unroll
                    for (int n = 0; n < 2; ++n) *(f32x4*)(kp + 32 * bj + 4 * n) = ks[bj][n];
            }
        }
    }
};
struct EpiOut {
    static constexpr bool PERM = false, AFTER_DRAIN = false;
    const float* base; float* out; bf16_t* xn; const float* gnext; float* ssq; int last;
    __device__ __forceinline__ void operator()(const f32x4 (&acc)[2][2][4][2], const Unit& u, int wr, int wc, int fr, int fq) const {
        typedef unsigned u32x2v __attribute__((ext_vector_type(2)));
        const int col0 = u.pn * BM + wc * 32 + 4 * fq;
        f32x4 gv[2][2];
#pragma unroll
        for (int bj = 0; bj < 2; ++bj)
#pragma unroll
            for (int n = 0; n < 2; ++n) gv[bj][n] = last ? (f32x4){0.f, 0.f, 0.f, 0.f} : *(const f32x4*)(gnext + col0 + bj * HALF + n * 16);
#pragma unroll
        for (int ai = 0; ai < 2; ++ai)
#pragma unroll
            for (int m = 0; m < 4; ++m) {
                const int row = u.pm * BM + ai * HALF + wr * 64 + m * 16 + fr; const size_t off = (size_t)row * 1024 + col0;
                float ss = 0.f;
#pragma unroll
                for (int bj = 0; bj < 2; ++bj)
#pragma unroll
                    for (int n = 0; n < 2; ++n) {
                        const f32x4 o = *(const f32x4*)(base + off + bj * HALF + n * 16) + acc[ai][bj][m][n];
                        *(f32x4*)(out + off + bj * HALF + n * 16) = o;
                        if (!last) { ss += (o[0] * o[0] + o[1] * o[1]) + (o[2] * o[2] + o[3] * o[3]); const f32x4 y = o * gv[bj][n];
                            u32x2v w; w.x = cvt_pk_bf16(y[0], y[1]); w.y = cvt_pk_bf16(y[2], y[3]); *(u32x2v*)(xn + off + bj * HALF + n * 16) = w; }
                    }
                if (!last) { ss += __shfl_xor(ss, 16); ss += __shfl_xor(ss, 32); if (fq == 0) ssq[(size_t)row * 16 + u.pn * 4 + wc] = ss; }
                if (m & 1) asm volatile("" ::: "memory");
            }
    }
};
template <class Epi, class Sched, bool ALIGN_EPI = false, bool SP2 = false>
__device__ __forceinline__ void gemm_phase(PG8_LAS unsigned char* lds, const Gemm g, const Sched& S, const Epi& E, const int tid) {
    const int wid = __builtin_amdgcn_readfirstlane(tid >> 6), lane = tid & 63, wr = wid >> 2, wc = wid & 3, fr = lane & 15, fq = lane >> 4;
    const int K = g.K, nt = K / BK;
    unsigned voffA[2], voffB[2];
#pragma unroll
    for (int i = 0; i < 2; ++i) { int R, C; stage_rc(tid * 16 + i * 8192, R, C); const int Rb = Epi::PERM ? ((R & ~31) + perm32(R & 31)) : R;
        voffA[i] = (unsigned)(R * K + C) * 2u; voffB[i] = (unsigned)(Rb * K + C) * 2u; }
    const size_t kstep = (size_t)(BK * 2);
    const size_t hstep = (size_t)HALF * K * 2;
    const size_t tstep = 2 * hstep;
    const unsigned ldsw = (unsigned)wid * 1024u;
    const int aoff = lds_byte(wr * 64 + fr, fq * 8), boff = lds_byte(wc * 32 + fr, fq * 8);
#define PG8_SA(b, h) (((b) * 2 + (h)) * HTB)
#define PG8_SB(b, h) ((4 + (b) * 2 + (h)) * HTB)
#define PG8_STAGE(bufoff, gbase, voff) do { _Pragma("unroll") for (int _i = 0; _i < 2; ++_i) \
        __builtin_amdgcn_global_load_lds((const unsigned*)((const char*)(gbase) + (voff)[_i]), (PG8_LAS unsigned*)(lds + (bufoff) + ldsw + _i * 8192), 16, 0, 0); } while (0)
#define PG8_LDA(dst, b, h) do { _Pragma("unroll") for (int m = 0; m < 4; ++m) _Pragma("unroll") for (int k = 0; k < 2; ++k) dst[m][k] = *(const PG8_LAS bf16x8*)(lds + PG8_SA(b, h) + aoff + m * 2048 + k * 1024); } while (0)
#define PG8_LDB(dst, b, h) do { _Pragma("unroll") for (int n = 0; n < 2; ++n) _Pragma("unroll") for (int k = 0; k < 2; ++k) dst[n][k] = *(const PG8_LAS bf16x8*)(lds + PG8_SB(b, h) + boff + n * 2048 + k * 1024); } while (0)
#define PG8_MMA(ai, bj, At, Bt) do { __builtin_amdgcn_s_setprio(1); _Pragma("unroll") for (int m = 0; m < 4; ++m) _Pragma("unroll") for (int n = 0; n < 2; ++n) _Pragma("unroll") for (int k = 0; k < 2; ++k) \
        acc[ai][bj][m][n] = __builtin_amdgcn_mfma_f32_16x16x32_bf16(Bt[n][k], At[m][k], acc[ai][bj][m][n], 0, 0, 0); __builtin_amdgcn_s_setprio(0); } while (0)
#define PG8_WAIT_V(n) asm volatile("s_waitcnt vmcnt(" #n ")" ::: "memory")
#define PG8_WAIT_L(n) asm volatile("s_waitcnt lgkmcnt(" #n ")" ::: "memory")
#define PG8_BAR __builtin_amdgcn_s_barrier()
#define PG8_SCHED __builtin_amdgcn_sched_barrier(0)
    Unit cur, nxt; int ui = 0;
    if (!S.next(0, cur)) return;
    f32x4 acc[2][2][4][2];
#pragma unroll
    for (int a = 0; a < 2; ++a)
#pragma unroll
        for (int b = 0; b < 2; ++b)
#pragma unroll
            for (int m = 0; m < 4; ++m)
#pragma unroll
                for (int n = 0; n < 2; ++n) acc[a][b][m][n] = (f32x4){0.f, 0.f, 0.f, 0.f};
    bf16x8 At[4][2], B0[2][2], B1[2][2];
    const char* cA = (const char*)g.A + (size_t)cur.pm * tstep; const char* cB = (const char*)g.Bt + (size_t)cur.pn * tstep;
    S.a_ready(cur);
    if constexpr (SP2) {
        PG8_STAGE(PG8_SB(0, 0), cB, voffB); PG8_STAGE(PG8_SB(0, 1), cB + hstep, voffB); PG8_STAGE(PG8_SA(0, 0), cA, voffA); PG8_STAGE(PG8_SA(0, 1), cA + hstep, voffA);
        if (wr == 1) PG8_BAR;
        PG8_WAIT_V(2); PG8_BAR;
        PG8_STAGE(PG8_SB(1, 0), cB + kstep, voffB); PG8_STAGE(PG8_SA(1, 0), cA + kstep, voffA); PG8_STAGE(PG8_SB(1, 1), cB + hstep + kstep, voffB);
        PG8_WAIT_V(6); PG8_BAR;
    } else {
        PG8_STAGE(PG8_SB(0, 0), cB, voffB); PG8_STAGE(PG8_SA(0, 0), cA, voffA); PG8_STAGE(PG8_SB(0, 1), cB + hstep, voffB); PG8_STAGE(PG8_SA(0, 1), cA + hstep, voffA);
        if (wr == 1) PG8_BAR;
        PG8_WAIT_V(4); PG8_BAR;
        PG8_STAGE(PG8_SB(1, 0), cB + kstep, voffB); PG8_STAGE(PG8_SA(1, 0), cA + kstep, voffA); PG8_STAGE(PG8_SB(1, 1), cB + hstep + kstep, voffB);
        PG8_WAIT_V(6); PG8_BAR;
    }
    for (;;) {
        const bool has_next = S.next(ui + 1, nxt);
        const char* nA = has_next ? (const char*)g.A + (size_t)nxt.pm * tstep : cA; const char* nB = has_next ? (const char*)g.Bt + (size_t)nxt.pn * tstep : cB;
        for (int t = 0; t < nt; t += 2) {
            const bool last = (t == nt - 2);
            const char* a1 = cA + (size_t)(t + 1) * kstep;
            const char* a2 = last ? nA : cA + (size_t)(t + 2) * kstep; const char* b2 = last ? nB : cB + (size_t)(t + 2) * kstep;
            const char* a3 = a2 + kstep; const char* b3 = b2 + kstep;
            if (last && has_next) S.a_ready(nxt);
            if constexpr (SP2) {
            PG8_LDB(B0, 0, 0); PG8_LDB(B1, 0, 1); PG8_SCHED; PG8_LDA(At, 0, 0); PG8_STAGE(PG8_SA(1, 1), a1 + hstep, voffA);
            PG8_WAIT_V(8); PG8_WAIT_L(0); PG8_BAR; PG8_MMA(0, 0, At, B0); PG8_MMA(0, 1, At, B1); PG8_BAR; PG8_SCHED;
            PG8_LDA(At, 0, 1); PG8_STAGE(PG8_SB(0, 0), b2, voffB); PG8_STAGE(PG8_SB(0, 1), b2 + hstep, voffB); PG8_STAGE(PG8_SA(0, 0), a2, voffA);
            PG8_WAIT_V(8); PG8_WAIT_L(0); PG8_BAR; PG8_MMA(1, 0, At, B0); PG8_MMA(1, 1, At, B1); PG8_BAR; PG8_SCHED;
            PG8_LDB(B0, 1, 0); PG8_LDB(B1, 1, 1); PG8_SCHED; PG8_LDA(At, 1, 0); PG8_STAGE(PG8_SA(0, 1), a2 + hstep, voffA);
            PG8_WAIT_V(8); PG8_WAIT_L(0); PG8_BAR; PG8_MMA(0, 0, At, B0); PG8_MMA(0, 1, At, B1); PG8_BAR; PG8_SCHED;
            PG8_LDA(At, 1, 1); PG8_STAGE(PG8_SB(1, 0), b3, voffB); PG8_STAGE(PG8_SB(1, 1), b3 + hstep, voffB); PG8_STAGE(PG8_SA(1, 0), a3, voffA);
            PG8_WAIT_V(8); PG8_WAIT_L(0); PG8_BAR; PG8_MMA(1, 0, At, B0); PG8_MMA(1, 1, At, B1); PG8_BAR; PG8_SCHED;
            } else {
            PG8_LDB(B0, 0, 0); PG8_SCHED; PG8_LDA(At, 0, 0); PG8_STAGE(PG8_SA(1, 1), a1 + hstep, voffA);
            PG8_WAIT_L(8); PG8_BAR; PG8_WAIT_L(0); PG8_MMA(0, 0, At, B0); PG8_BAR; PG8_SCHED;
            PG8_LDB(B1, 0, 1); PG8_STAGE(PG8_SB(0, 0), b2, voffB);
            PG8_BAR; PG8_WAIT_L(0); PG8_MMA(0, 1, At, B1); PG8_BAR;
            PG8_LDA(At, 0, 1); PG8_STAGE(PG8_SA(0, 0), a2, voffA);
            PG8_BAR; PG8_WAIT_L(0); PG8_MMA(1, 0, At, B0); PG8_BAR; PG8_SCHED;
            PG8_STAGE(PG8_SB(0, 1), b2 + hstep, voffB);
            PG8_WAIT_V(6); PG8_BAR; PG8_MMA(1, 1, At, B1); PG8_BAR;
            PG8_LDB(B0, 1, 0); PG8_SCHED; PG8_LDA(At, 1, 0); PG8_STAGE(PG8_SA(0, 1), a2 + hstep, voffA);
            PG8_WAIT_L(8); PG8_BAR; PG8_WAIT_L(0); PG8_MMA(0, 0, At, B0); PG8_BAR; PG8_SCHED;
            PG8_LDB(B1, 1, 1); PG8_STAGE(PG8_SB(1, 0), b3, voffB);
            PG8_BAR; PG8_WAIT_L(0); PG8_MMA(0, 1, At, B1); PG8_BAR;
            PG8_LDA(At, 1, 1); PG8_STAGE(PG8_SA(1, 0), a3, voffA);
            PG8_BAR; PG8_WAIT_L(0); PG8_MMA(1, 0, At, B0); PG8_BAR; PG8_SCHED;
            PG8_STAGE(PG8_SB(1, 1), b3 + hstep, voffB);
            PG8_WAIT_V(6); PG8_BAR; PG8_MMA(1, 1, At, B1); PG8_BAR;
            }
        }
        if constexpr (ALIGN_EPI) { if (wr == 0) PG8_BAR; }
        if constexpr (!Epi::AFTER_DRAIN) { E(acc, cur, wr, wc, fr, fq); S.done(cur); }
        if (!has_next) break;
#pragma unroll
        for (int a = 0; a < 2; ++a)
#pragma unroll
            for (int b = 0; b < 2; ++b)
#pragma unroll
                for (int m = 0; m < 4; ++m)
#pragma unroll
                    for (int n = 0; n < 2; ++n) acc[a][b][m][n] = (f32x4){0.f, 0.f, 0.f, 0.f};
        cur = nxt; cA = nA; cB = nB; ++ui;
        if constexpr (ALIGN_EPI) { if (wr == 1) PG8_BAR; }
    }
    PG8_WAIT_V(0);
    if constexpr (!ALIGN_EPI) { if (wr == 0) PG8_BAR; }
    PG8_BAR;
    if constexpr (Epi::AFTER_DRAIN) { E.fused(acc, cur, wr, wc, fr, fq, lds, wid, lane); S.done(cur); }
#undef PG8_SA
#undef PG8_SB
#undef PG8_STAGE
#undef PG8_LDA
#undef PG8_LDB
#undef PG8_MMA
#undef PG8_WAIT_V
#undef PG8_WAIT_L
#undef PG8_BAR
#undef PG8_SCHED
}
}

#ifndef PG8_SP2
#define PG8_SP2 true
#endif
#ifndef PG8_ALIGN
#define PG8_ALIGN true
#endif
#include <hip/hip_bf16.h>
#include <cmath>
namespace attn_body {
using bf16=__hip_bfloat16;
using bf16x8=__attribute__((ext_vector_type(8)))short;
using s16x4=__attribute__((ext_vector_type(4)))short;
using f32x16=__attribute__((ext_vector_type(16)))float;
using u32x4=__attribute__((ext_vector_type(4)))unsigned;
constexpr int SEQ=4096,D=64,PQ=512,PO=1024;
constexpr int NW=8,QBLK=32,QB=QBLK*NW,KVBLK=64,NQB=SEQ/QB;
constexpr int ATTN_UNIT_ROWS=QB;
__device__ __forceinline__ int crow(int r,int hi){return (r&3)+8*(r>>2)+4*hi;}
#define SBAR() __builtin_amdgcn_sched_barrier(0)
__device__ __forceinline__ void cmask(f32x16&p0,f32x16&p1,int jb,int qrel,int hi){
  const float NEG=-INFINITY; const int x=qrel-4*hi-64*jb;
  #pragma unroll
  for(int r=0;r<16;++r){const int c=(r&3)+8*(r>>2); if(c>x)p0[r]=NEG; if(c+32>x)p1[r]=NEG;}
}

constexpr int NSLOT=3, SLOTB=8192;
constexpr int LDS_K=0, LDS_V=NSLOT*SLOTB, LDS_WS=2*NSLOT*SLOTB, LDS_OST=LDS_WS+NW*64*4, LDS_BYTES=LDS_OST+NW*4096;
constexpr float C2=0.125f*1.4426950408889634f;
__device__ __forceinline__ void glds16(const void*gsrc,unsigned lds_dst){unsigned keep;
  asm volatile("s_mov_b32 %0, m0\n\ts_mov_b32 m0, %2\n\ts_nop 0\n\tglobal_load_lds_dwordx4 %1, off\n\ts_mov_b32 m0, %0":"=&s"(keep):"v"(gsrc),"s"(lds_dst):"memory");}
__device__ __forceinline__ float max3f(float a,float b,float c){float r;asm("v_max3_f32 %0, %1, %2, %3":"=v"(r):"v"(a),"v"(b),"v"(c));return r;}
__device__ __forceinline__ float max2f(float a,float b){float r;asm("v_max_f32_e32 %0, %1, %2":"=v"(r):"v"(a),"v"(b));return r;}
__device__ __forceinline__ float fadd_s(float a,float b){float r;asm("v_add_f32_e32 %0, %1, %2":"=v"(r):"v"(a),"v"(b));return r;}
__device__ __forceinline__ float fsub_s(float a,float b){float r;asm("v_sub_f32_e32 %0, %1, %2":"=v"(r):"v"(a),"v"(b));return r;}
typedef float f32x2_t __attribute__((ext_vector_type(2))); typedef __bf16 bf16x2_t __attribute__((ext_vector_type(2)));
__device__ __forceinline__ unsigned cvtpk_s(float lo,float hi){f32x2_t v={lo,hi};bf16x2_t b=__builtin_convertvector(v,bf16x2_t);return __builtin_bit_cast(unsigned,b);}
#define WAIT_BAR(N) asm volatile("s_waitcnt vmcnt(" #N ") lgkmcnt(0)\n\ts_barrier":::"memory")

__device__ __forceinline__ void qkt(f32x16&p0,f32x16&p1,const char*Kslot,const bf16x8*qr,const f32x16&negm,int r32,int hi){
  const char*kb=Kslot+hi*1024+r32*16;
  #pragma unroll
  for(int d0=0;d0<4;++d0){
    const bf16x8 b0=*reinterpret_cast<const bf16x8*>(kb+d0*2048);
    const bf16x8 b1=*reinterpret_cast<const bf16x8*>(kb+d0*2048+512);
    if(d0==0){p0=__builtin_amdgcn_mfma_f32_32x32x16_bf16(b0,qr[0],negm,0,0,0);p1=__builtin_amdgcn_mfma_f32_32x32x16_bf16(b1,qr[0],negm,0,0,0);}
    else{p0=__builtin_amdgcn_mfma_f32_32x32x16_bf16(b0,qr[d0],p0,0,0,0);p1=__builtin_amdgcn_mfma_f32_32x32x16_bf16(b1,qr[d0],p1,0,0,0);}}
}
typedef __attribute__((address_space(3))) const char* lds_cptr;
typedef short v4i16_t __attribute__((ext_vector_type(4)));
__device__ __forceinline__ void kload8(bf16x8*kf,lds_cptr kp){
  kf[0]=*(const __attribute__((address_space(3))) bf16x8*)(kp);      kf[1]=*(const __attribute__((address_space(3))) bf16x8*)(kp+512);
  kf[2]=*(const __attribute__((address_space(3))) bf16x8*)(kp+2048); kf[3]=*(const __attribute__((address_space(3))) bf16x8*)(kp+2560);
  kf[4]=*(const __attribute__((address_space(3))) bf16x8*)(kp+4096); kf[5]=*(const __attribute__((address_space(3))) bf16x8*)(kp+4608);
  kf[6]=*(const __attribute__((address_space(3))) bf16x8*)(kp+6144); kf[7]=*(const __attribute__((address_space(3))) bf16x8*)(kp+6656);
}
__device__ __forceinline__ void kload2(bf16x8*kf,lds_cptr kp,int j){ kf[2*j]=*(const __attribute__((address_space(3))) bf16x8*)(kp+j*2048); kf[2*j+1]=*(const __attribute__((address_space(3))) bf16x8*)(kp+j*2048+512); }
__device__ __forceinline__ s16x4 vtr(lds_cptr p){ return __builtin_bit_cast(s16x4,__builtin_amdgcn_ds_read_tr16_b64_v4i16((__attribute__((address_space(3))) v4i16_t*)p)); }
__device__ __forceinline__ float rowmax(const f32x16&p0,const f32x16&p1){
  float a=max3f(p0[0],p0[1],p1[0]),b=max3f(p0[2],p0[3],p1[1]);a=max3f(a,p1[2],p1[3]);
  #pragma unroll
  for(int r=4;r<16;r+=4){a=max3f(a,p0[r],p0[r+1]);b=max3f(b,p0[r+2],p0[r+3]);a=max3f(a,p1[r],p1[r+1]);b=max3f(b,p1[r+2],p1[r+3]);}
  const float m=max2f(a,b);
  auto rr=__builtin_amdgcn_permlane32_swap(__float_as_uint(m),__float_as_uint(m),false,false);
  return max2f(__uint_as_float(rr[0]),__uint_as_float(rr[1]));
}
__device__ __forceinline__ void pv(f32x16*o,int vb,bf16x8 pa0,bf16x8 pa1,bf16x8 pa2,bf16x8 pa3){
  #pragma unroll
  for(int d0=0;d0<2;++d0){s16x4 lo[4],hi[4];
    #pragma unroll
    for(int ks=0;ks<4;++ks){
      asm volatile("ds_read_b64_tr_b16 %0,%1 offset:%c2":"=&v"(lo[ks]):"v"(vb),"i"(d0*4096+ks*1024):"memory");
      asm volatile("ds_read_b64_tr_b16 %0,%1 offset:%c2":"=&v"(hi[ks]):"v"(vb),"i"(d0*4096+ks*1024+512):"memory");}
    asm volatile("s_waitcnt lgkmcnt(0)":::"memory");SBAR();
    #define PK(k) (bf16x8){lo[k][0],lo[k][1],lo[k][2],lo[k][3],hi[k][0],hi[k][1],hi[k][2],hi[k][3]}
    o[d0]=__builtin_amdgcn_mfma_f32_32x32x16_bf16(pa0,PK(0),o[d0],0,0,0);
    o[d0]=__builtin_amdgcn_mfma_f32_32x32x16_bf16(pa1,PK(1),o[d0],0,0,0);
    o[d0]=__builtin_amdgcn_mfma_f32_32x32x16_bf16(pa2,PK(2),o[d0],0,0,0);
    o[d0]=__builtin_amdgcn_mfma_f32_32x32x16_bf16(pa3,PK(3),o[d0],0,0,0);
    #undef PK
  }
}

#ifndef ATTN_STORE16
#define ATTN_STORE16(p,v) (*(u32x4*)(p)=(v))
#endif
struct UnitDesc { const bf16*Q; const bf16*K; const bf16*V; bf16*O; const bf16*G; const float*KM; float a2; int qb; };
template<int THRL> __device__ __forceinline__ void attn_unit(const UnitDesc&U,char*shm,const int tid){
  const bf16*Q=U.Q; const bf16*__restrict__ K=U.K; const bf16*__restrict__ V=U.V; bf16*O=U.O; const int qb=U.qb; const float a2=U.a2;
  const int lane=tid&63,r32=lane&31,hi=lane>>5; const int wid=__builtin_amdgcn_readfirstlane(tid>>6);
  const int q0=qb*QB;
  const bf16*Qw=Q+(long)(q0+wid*QBLK)*PQ;
  const bf16*Kh=K,*Vh=V;
  const unsigned lds0=(unsigned)(uintptr_t)shm;
  float*wsf=(float*)(shm+LDS_WS)+wid*64;
  const bf16*ksrc=Kh+(long)lane*PQ+wid*8;
  const bf16*vsrc=Vh+(long)(16*(wid&3)+(lane>>2))*PQ+(wid>>2)*32+(lane&3)*8;
  const unsigned kdst=lds0+LDS_K+wid*1024, vdst=lds0+LDS_V+wid*1024;
  #define KT(t) (((t)<4)?(NT-4+(t)):(NT-1-(t)))
  #define DMA_K(t,slot) glds16(ksrc+(long)KT(t)*KVBLK*PQ,(unsigned)__builtin_amdgcn_readfirstlane(kdst+(slot)))
  #define DMA_V(t,slot) glds16(vsrc+(long)KT(t)*KVBLK*PQ,(unsigned)__builtin_amdgcn_readfirstlane(vdst+(slot)))
  const int vb0=(int)(lds0+LDS_V)+((lane>>4)&1)*32+(lane&3)*8+(4*hi+((lane&15)>>2))*64;
  const char*Kbase=shm+LDS_K; bf16x8 kf[8];
  const lds_cptr shm3=(lds_cptr)shm; const lds_cptr kp0=shm3+LDS_K+hi*1024+r32*16; const lds_cptr vp0=shm3+LDS_V+((lane>>4)&1)*32+(lane&3)*8+(4*hi+((lane&15)>>2))*64;
  const int NT=(q0+QB)/KVBLK;
  unsigned selmask=0xFFFFu;
  if(U.KM!=nullptr && qb>0){
    float*kml=(float*)(shm+LDS_OST);
    int lane_g=lane; asm volatile("":"+v"(lane_g));
    const int r32=lane_g&31,hi=lane_g>>5;
    for(int i=wid*64+lane_g;i<1024;i+=NW*64){ const int j=i>>6,d=i&63; kml[i]=(j<qb)?(U.KM[(j*2)*64+d]+U.KM[(j*2+1)*64+d]):0.f; }
    __syncthreads();
    float g[8];
    #pragma unroll
    for(int j=0;j<8;++j)g[j]=0.f;
    const bf16*qrow=Q+(long)(q0+wid*QBLK+r32)*PQ;
    #pragma unroll
    for(int c=0;c<8;++c){ const u32x4 qv=*reinterpret_cast<const u32x4*>(qrow+c*8); float qf[8];
      qf[0]=__uint_as_float(qv.x<<16);qf[1]=__uint_as_float(qv.x&0xffff0000u);qf[2]=__uint_as_float(qv.y<<16);qf[3]=__uint_as_float(qv.y&0xffff0000u);
      qf[4]=__uint_as_float(qv.z<<16);qf[5]=__uint_as_float(qv.z&0xffff0000u);qf[6]=__uint_as_float(qv.w<<16);qf[7]=__uint_as_float(qv.w&0xffff0000u);
      #pragma unroll
      for(int j=0;j<8;++j){ const float*kp=kml+(8*hi+j)*64+c*8;
        #pragma unroll
        for(int e=0;e<8;++e)g[j]=__builtin_fmaf(qf[e],kp[e],g[j]); } }
    float all[16];
    #pragma unroll
    for(int j=0;j<8;++j){ if(8*hi+j>=qb)g[j]=-INFINITY; auto rr=__builtin_amdgcn_permlane32_swap(__float_as_uint(g[j]),__float_as_uint(g[j]),false,false); all[j]=__uint_as_float(rr[0]); all[8+j]=__uint_as_float(rr[1]); }
    unsigned m=0u;
    #pragma unroll
    for(int k=0;k<3;++k){ float best=-INFINITY; int bi=-1;
      #pragma unroll
      for(int j=0;j<16;++j){ const bool c=(((m>>j)&1u)==0u)&&(all[j]>best); best=c?all[j]:best; bi=c?j:bi; }
      if(bi>=0)m|=(1u<<bi); }
    selmask=m;
    __syncthreads();
  }
  DMA_K(0,0);DMA_V(0,0);DMA_K(1,SLOTB);
  bf16x8 qr[4];
  #pragma unroll
  for(int d0=0;d0<4;++d0)qr[d0]=*reinterpret_cast<const bf16x8*>(&Qw[(long)r32*PQ+d0*16+hi*8]);
  float mhat=0.f,l_reg=0.f;f32x16 o[2];o[0]=f32x16{};o[1]=f32x16{};const f32x16 negm=f32x16{};
  const int qrel=wid*QBLK+r32;
  #define CMASK(P0,P1,t) do{ if((t)<4)cmask(P0,P1,(t),qrel,hi); }while(0)
  const int qend=q0+QB-1;
  #define ALIBI(P0,P1,t) do{ const int kt_=KT(t); float tb_=a2*(float)(64*kt_+4*hi-qend)-mhat; \
    if((t)>=4 && (((selmask>>(kt_>>2))&1u)==0u)) tb_=-INFINITY; \
    const float a8_=a2*8.0f, a32_=a2*32.0f; \
    _Pragma("unroll") for(int g_=0;g_<4;++g_){ const float b0_=tb_, b1_=tb_+a2, b2_=tb_+2.0f*a2, b3_=tb_+(a2+2.0f*a2); \
      P0[4*g_+0]+=b0_; P0[4*g_+1]+=b1_; P0[4*g_+2]+=b2_; P0[4*g_+3]+=b3_; \
      P1[4*g_+0]+=b0_+a32_; P1[4*g_+1]+=b1_+a32_; P1[4*g_+2]+=b2_+a32_; P1[4*g_+3]+=b3_+a32_; tb_+=a8_; } }while(0)
  bool resc=false;
  #define START(P0,P1) do{ const float rm=rowmax(P0,P1); resc=false; \
    { const float dl=rm; mhat=fadd_s(mhat,dl); \
      _Pragma("unroll") for(int r=0;r<16;++r){P0[r]=fsub_s(P0[r],dl);P1[r]=fsub_s(P1[r],dl);} \
      } \
    _Pragma("unroll") for(int r=0;r<16;++r)P0[r]=__builtin_amdgcn_exp2f(P0[r]); }while(0)
  #define RESC() do{ if(resc){ asm volatile("s_waitcnt lgkmcnt(0)":::"memory"); \
      _Pragma("unroll") for(int d_=0;d_<2;++d_) _Pragma("unroll") for(int r=0;r<16;++r)o[d_][r]*=wsf[crow(r,hi)]; } }while(0)
  f32x16 pA0,pA1,pB0,pB1;
  int sl_prev=0,sl_cur=0,sl_next=SLOTB;
  #define ROT() do{sl_prev=sl_cur;sl_cur=sl_next;sl_next=(sl_next==(NSLOT-1)*SLOTB)?0:sl_next+SLOTB;}while(0)
  DMA_K(2,2*SLOTB);
  WAIT_BAR(3);
  qkt(pA0,pA1,Kbase,qr,negm,r32,hi);asm volatile("s_nop 15\n\ts_nop 7":"+v"(pA0),"+v"(pA1));ALIBI(pA0,pA1,0);CMASK(pA0,pA1,0);
  START(pA0,pA1);
  _Pragma("unroll") for(int r=0;r<16;++r)pA1[r]=__builtin_amdgcn_exp2f(pA1[r]);
  WAIT_BAR(0);
  DMA_K(3,0);DMA_V(1,SLOTB);
  ROT();
  kload8(kf,kp0+sl_cur);
  WAIT_BAR(2);
  s16x4 vlo[8],vhi[8]; u32x4 pw0,pw1,pw2,pw3;
  #define PKW(P,B) cvtpk_s(P[B],P[B+1])
  #define PAF(k) __builtin_bit_cast(bf16x8,pw##k)
  #define VFR(i) (bf16x8){vlo[i][0],vlo[i][1],vlo[i][2],vlo[i][3],vhi[i][0],vhi[i][1],vhi[i][2],vhi[i][3]}
  #define PIN(x) asm volatile("":"+v"(x))
  #define MX3(a,b,c) __builtin_fmaxf(__builtin_fmaxf((a),(b)),(c))
  #define GAPA(MF,A0,A1,A2,A3,W0,W1,PW) do{ MF; sacc+=A0; sacc+=A1; sacc+=A2; sacc+=A3; PIN(sacc); W0; W1; PIN(PW); SBAR(); }while(0)
  #define EX(v) __builtin_amdgcn_exp2f(v)
  #define GAPB(MF,X,B) do{ MF; X[B]=EX(X[B]); X[B+1]=EX(X[B+1]); X[B+2]=EX(X[B+2]); X[B+3]=EX(X[B+3]); PIN(X); SBAR(); }while(0)
  #define VRD(i) do{ vlo[i]=vtr(vp_+(((i)>>2)*4096+((i)&3)*1024)); vhi[i]=vtr(vp_+(((i)>>2)*4096+((i)&3)*1024+512)); }while(0)
  #define KRD(G,j) do{ if(G){ kload2(kf,kp0+sl_next,j); SBAR(); } }while(0)
  #define STEP(C0,C1,P0,P1,t,GK,GV,GL) do{ SBAR(); \
    const lds_cptr vp_=vp0+sl_prev; \
    VRD(0); SBAR(); float sacc=(P0[0]+P0[1]); \
    GAPA(C0=__builtin_amdgcn_mfma_f32_32x32x16_bf16(kf[0],qr[0],negm,0,0,0), P0[2],P0[3],P0[4],P0[5],     pw0[0]=PKW(P0,0), pw0[1]=PKW(P0,2), pw0); \
    VRD(4); SBAR(); GAPA(C1=__builtin_amdgcn_mfma_f32_32x32x16_bf16(kf[1],qr[0],negm,0,0,0), P0[6],P0[7],P0[8],P0[9],     pw0[2]=PKW(P0,4), pw0[3]=PKW(P0,6), pw0); \
    VRD(1); SBAR(); GAPA(C0=__builtin_amdgcn_mfma_f32_32x32x16_bf16(kf[2],qr[1],C0,0,0,0),   P0[10],P0[11],P0[12],P0[13], pw1[0]=PKW(P0,8), pw1[1]=PKW(P0,10), pw1); \
    VRD(5); SBAR(); GAPA(C1=__builtin_amdgcn_mfma_f32_32x32x16_bf16(kf[3],qr[1],C1,0,0,0),   P0[14],P0[15],P1[0],P1[1],   pw1[2]=PKW(P0,12),pw1[3]=PKW(P0,14), pw1); \
    VRD(2); SBAR(); GAPA(C0=__builtin_amdgcn_mfma_f32_32x32x16_bf16(kf[4],qr[2],C0,0,0,0),   P1[2],P1[3],P1[4],P1[5],     pw2[0]=PKW(P1,0), pw2[1]=PKW(P1,2), pw2); \
    VRD(6); SBAR(); GAPA(C1=__builtin_amdgcn_mfma_f32_32x32x16_bf16(kf[5],qr[2],C1,0,0,0),   P1[6],P1[7],P1[8],P1[9],     pw2[2]=PKW(P1,4), pw2[3]=PKW(P1,6), pw2); \
    VRD(3); SBAR(); GAPA(C0=__builtin_amdgcn_mfma_f32_32x32x16_bf16(kf[6],qr[3],C0,0,0,0),   P1[10],P1[11],P1[12],P1[13], pw3[0]=PKW(P1,8), pw3[1]=PKW(P1,10), pw3); \
    VRD(7); SBAR(); GAPA(C1=__builtin_amdgcn_mfma_f32_32x32x16_bf16(kf[7],qr[3],C1,0,0,0),   P1[14],P1[15],0.f,0.f,       pw3[2]=PKW(P1,12),pw3[3]=PKW(P1,14), pw3); \
    l_reg+=sacc; \
    if(GK){DMA_K((t)+3,sl_cur);} if(GV){DMA_V((t)+1,sl_next);} \
    ALIBI(C0,C1,t); CMASK(C0,C1,t); \
    { float a=MX3(C0[0],C0[1],C1[0]),b=MX3(C0[2],C0[3],C1[1]); a=MX3(a,C1[2],C1[3]); \
      _Pragma("unroll") for(int r=4;r<16;r+=4){a=MX3(a,C0[r],C0[r+1]);b=MX3(b,C0[r+2],C0[r+3]);a=MX3(a,C1[r],C1[r+1]);b=MX3(b,C1[r+2],C1[r+3]);} \
      float rm=__builtin_fmaxf(a,b); { auto rr=__builtin_amdgcn_permlane32_swap(__float_as_uint(rm),__float_as_uint(rm),false,false); rm=__builtin_fmaxf(__uint_as_float(rr[0]),__uint_as_float(rr[1])); } \
      resc=false; \
      if(__builtin_expect(__any(rm>(float)THRL),0)){ const float dl=__builtin_fmaxf(rm,0.f); mhat+=dl; \
        _Pragma("unroll") for(int r=0;r<16;++r){C0[r]-=dl;C1[r]-=dl;} \
        const float f=__builtin_amdgcn_exp2f(-dl); l_reg*=f; if(hi==0)wsf[r32]=f; resc=true; } } \
    SBAR(); \
    GAPB(o[0]=__builtin_amdgcn_mfma_f32_32x32x16_bf16(PAF(0),VFR(0),o[0],0,0,0), C0,0); \
    GAPB(o[1]=__builtin_amdgcn_mfma_f32_32x32x16_bf16(PAF(0),VFR(4),o[1],0,0,0), C0,4); \
    KRD(GL,0); GAPB(o[0]=__builtin_amdgcn_mfma_f32_32x32x16_bf16(PAF(1),VFR(1),o[0],0,0,0), C0,8); \
    KRD(GL,1); GAPB(o[1]=__builtin_amdgcn_mfma_f32_32x32x16_bf16(PAF(1),VFR(5),o[1],0,0,0), C0,12); \
    KRD(GL,2); GAPB(o[0]=__builtin_amdgcn_mfma_f32_32x32x16_bf16(PAF(2),VFR(2),o[0],0,0,0), C1,0); \
    KRD(GL,3); GAPB(o[1]=__builtin_amdgcn_mfma_f32_32x32x16_bf16(PAF(2),VFR(6),o[1],0,0,0), C1,4); \
    GAPB(o[0]=__builtin_amdgcn_mfma_f32_32x32x16_bf16(PAF(3),VFR(3),o[0],0,0,0), C1,8); \
    GAPB(o[1]=__builtin_amdgcn_mfma_f32_32x32x16_bf16(PAF(3),VFR(7),o[1],0,0,0), C1,12); \
    }while(0)
  #define ENDW(tt) do{ if((tt)+3<NT){WAIT_BAR(2);} else if((tt)+2<NT){WAIT_BAR(1);} else {WAIT_BAR(0);} }while(0)
  int t=1;
  for(;t+1<NT;t+=2){
    STEP(pB0,pB1,pA0,pA1,t,(t+3<NT),(t+1<NT),(t+1<NT));       ENDW(t);   RESC(); ROT();
    STEP(pA0,pA1,pB0,pB1,t+1,(t+4<NT),(t+2<NT),(t+2<NT));     ENDW(t+1); RESC(); ROT();
  }
  STEP(pB0,pB1,pA0,pA1,NT-1,false,false,false); RESC();
  { float sacc=pB0[0]+pB0[1]; _Pragma("unroll") for(int r=2;r<16;++r)sacc+=pB0[r]; _Pragma("unroll") for(int r=0;r<16;++r)sacc+=pB1[r]; l_reg+=sacc;
    pw0=(u32x4){PKW(pB0,0),PKW(pB0,2),PKW(pB0,4),PKW(pB0,6)};pw1=(u32x4){PKW(pB0,8),PKW(pB0,10),PKW(pB0,12),PKW(pB0,14)};pw2=(u32x4){PKW(pB1,0),PKW(pB1,2),PKW(pB1,4),PKW(pB1,6)};pw3=(u32x4){PKW(pB1,8),PKW(pB1,10),PKW(pB1,12),PKW(pB1,14)};
    SBAR(); pv(o,vb0+sl_cur,PAF(0),PAF(1),PAF(2),PAF(3)); }
  #undef PKW
  #undef PAF
  #undef VFR
  #undef PIN
  #undef MX3
  #undef GAPA
  #undef GAPB
  #undef EX
  #undef VRD
  #undef KRD
  #undef STEP
  #undef ENDW
  {auto rr=__builtin_amdgcn_permlane32_swap(__float_as_uint(l_reg),__float_as_uint(l_reg),false,false);l_reg=__uint_as_float(rr[0])+__uint_as_float(rr[1]);}
  if(hi==0)wsf[32+r32]=l_reg;asm volatile("s_waitcnt lgkmcnt(0)":::"memory");
  int lane_e=lane; asm volatile("":"+v"(lane_e));
  const int hi_e=lane_e>>5,r32_e=lane_e&31;
  float rli[16];
  #pragma unroll
  for(int r=0;r<16;++r)rli[r]=__builtin_amdgcn_rcpf(wsf[32+crow(r,0)+4*hi_e]);
  bf16*Ow=O+(long)(q0+wid*QBLK)*PO; const bf16*Gw=U.G?U.G+(long)(q0+wid*QBLK)*PQ:nullptr;
  { bf16*stg=(bf16*)(shm+LDS_OST)+wid*2048;
    bf16*stw=stg+hi_e*256+r32_e;
    #pragma unroll
    for(int r=0;r<16;++r){const int orow=crow(r,0);
      #pragma unroll
      for(int d0=0;d0<2;++d0)stw[orow*64+d0*32]=__float2bfloat16(o[d0][r]*rli[r]);}
    asm volatile("s_waitcnt lgkmcnt(0)":::"memory");
    #pragma unroll
    for(int i=0;i<4;++i){const int row=i*8+(lane_e>>3),ch=lane_e&7; u32x4 v=*(const u32x4*)(stg+row*64+ch*8);
      if(Gw){ const u32x4 gg=*reinterpret_cast<const u32x4*>(Gw+(long)row*PQ+ch*8);
        #define MULPK(a,b) cvtpk_s(__uint_as_float((a)<<16)*__uint_as_float((b)<<16),__uint_as_float((a)&0xffff0000u)*__uint_as_float((b)&0xffff0000u))
        v.x=MULPK(v.x,gg.x);v.y=MULPK(v.y,gg.y);v.z=MULPK(v.z,gg.z);v.w=MULPK(v.w,gg.w);
        #undef MULPK
      }
      ATTN_STORE16(Ow+(long)row*PO+ch*8,v);} }
  asm volatile("s_waitcnt lgkmcnt(0)\n\ts_barrier":::"memory");
  #undef DMA_K
  #undef DMA_V
  #undef KT
  #undef ALIBI
  #undef CMASK
  #undef START
  #undef RESC
  #undef ROT
}
constexpr int ATTN_LDS_BYTES=LDS_BYTES;
#undef SBAR
#undef WAIT_BAR
}
#define GAS __attribute__((address_space(1)))
#define LAS __attribute__((address_space(3)))
typedef unsigned short bf16;
typedef unsigned v4u __attribute__((ext_vector_type(4)));
typedef float f32x4 __attribute__((ext_vector_type(4)));
typedef short bf16x8 __attribute__((ext_vector_type(8)));
typedef GAS unsigned gu32;
typedef GAS unsigned long long gu64;
#define RLX_AGENT __ATOMIC_RELAXED, __HIP_MEMORY_SCOPE_AGENT
#define LDS_WAIT() asm volatile("s_waitcnt lgkmcnt(0)" ::: "memory")
#define VM_WAIT() asm volatile("s_waitcnt vmcnt(0)" ::: "memory")
__device__ __forceinline__ unsigned long long rt() { return __builtin_amdgcn_s_memrealtime(); }
__device__ __forceinline__ unsigned f2bf(float f) { unsigned u = __builtin_bit_cast(unsigned, f); return (u + 0x7fffu + ((u >> 16) & 1u)) >> 16; }
__device__ __forceinline__ unsigned pk2(float lo, float hi) { return f2bf(lo) | (f2bf(hi) << 16); }

#define XB_TMO      128
#define XB_XCNT(j)  (256  + 64 * (j))
#define XB_XSUB(j)  (1280 + 64 * (j))
#define XB_XGEN(j)  (2304 + 64 * (j))
#define XB_TOP      3328
#define XB_TOPGEN   3392
#define XCD_BAR_WORDS 3456
#define XB_SPIN_CAP (1u << 18)

__device__ __forceinline__ unsigned xb_ld(unsigned* p)              { return __hip_atomic_load(p, __ATOMIC_RELAXED, __HIP_MEMORY_SCOPE_AGENT); }
__device__ __forceinline__ unsigned xb_add(unsigned* p, unsigned v) { return __hip_atomic_fetch_add(p, v, __ATOMIC_RELAXED, __HIP_MEMORY_SCOPE_AGENT); }
__device__ __forceinline__ unsigned xb_xcc_id() { return (unsigned)__builtin_amdgcn_s_getreg((3 << 11) | 20) & 0xFu; }
#define XB_SPIN(cond, bar) do { unsigned _sp = 0; while (cond) { __builtin_amdgcn_s_sleep(1); \
    if ((++_sp & 255u) == 0u) { if (xb_ld(&(bar)[XB_TMO])) break; if (_sp > XB_SPIN_CAP) { atomicAdd(&(bar)[XB_TMO], 1u); break; } } } } while (0)

struct XcdBarrier {
    unsigned* bar; unsigned x;
    volatile LAS unsigned* st;
};

__device__ __forceinline__ XcdBarrier xcd_barrier_post(unsigned* bar, volatile LAS unsigned* st, const int tid) {
    XcdBarrier b; b.bar = bar; b.x = xb_xcc_id(); b.st = st;
    if (tid == 0) (void)xb_add(&bar[XB_XCNT(b.x)], 1u);
    return b;
}
__device__ __forceinline__ void xcd_barrier_complete(unsigned* bar, unsigned x, unsigned& nloc, unsigned& nx) {
    const unsigned G = gridDim.x * gridDim.y * gridDim.z;
    unsigned sum, cnt, mine, sp = 0u;
    for (;;) {
        sum = 0u; cnt = 0u; mine = 0u;
#pragma unroll 1
        for (unsigned j = 0; j < 16; ++j) { const unsigned c = xb_ld(&bar[XB_XCNT(j)]); sum += c; cnt += (c > 0u) ? 1u : 0u; mine = (j == x) ? c : mine; }
        if (sum == G) break;
        __builtin_amdgcn_s_sleep(1);
        if ((++sp & 255u) == 0u) { if (xb_ld(&bar[XB_TMO])) break; if (sp > XB_SPIN_CAP) { atomicAdd(&bar[XB_TMO], 1u); break; } }
    }
    nloc = mine > 0u ? mine : 1u; nx = cnt > 0u ? cnt : 1u;
}

__device__ __forceinline__ void xcd_barrier(const XcdBarrier& b, const int tid) {
    asm volatile("s_waitcnt vmcnt(0)" ::: "memory");
    __syncthreads();
    if (tid == 0) {
        unsigned* bar = b.bar;
        __builtin_amdgcn_s_waitcnt(0);
        unsigned nloc = b.st[0], nx = b.st[1];
        if (nloc == 0u) { xcd_barrier_complete(bar, b.x, nloc, nx); b.st[0] = nloc; b.st[1] = nx; }
        const unsigned old = xb_add(&bar[XB_XSUB(b.x)], 1u);
        const unsigned gen = old / nloc;
        if (old + 1u == (gen + 1u) * nloc) {
            __builtin_amdgcn_fence(__ATOMIC_RELEASE, "agent");
            asm volatile("s_waitcnt vmcnt(0)" ::: "memory");
            const unsigned og = xb_add(&bar[XB_TOP], 1u);
            const unsigned tg = og / nx;
            if (og + 1u == (tg + 1u) * nx) xb_add(&bar[XB_TOPGEN], 1u);
            else XB_SPIN(xb_ld(&bar[XB_TOPGEN]) == tg, bar);
            __builtin_amdgcn_fence(__ATOMIC_ACQUIRE, "agent");
            xb_add(&bar[XB_XGEN(b.x)], 1u);
            asm volatile("s_waitcnt vmcnt(0)" ::: "memory");
        } else {
            XB_SPIN(xb_ld(&bar[XB_XGEN(b.x)]) == gen, bar);
            __builtin_amdgcn_fence(__ATOMIC_ACQUIRE, "agent");
            asm volatile("s_waitcnt vmcnt(0)" ::: "memory");
        }
    }
    __syncthreads();
}
constexpr int NWAVES = 8;
#ifndef MK_PER_PHASE
#define MK_PER_PHASE 0
#endif
constexpr int BATCH = 8, SEQ = 4096, D = 1024, DEPTH = 2, INW = 4096;
constexpr int M = BATCH * SEQ;
constexpr float NORM_EPS = 1e-6f;
constexpr int N_PHASES = 1 + 4 * DEPTH;

constexpr size_t MiB = 1u << 20;
constexpr size_t WS_CTL = 0, CTL_ZERO_BYTES = 1 * MiB;
constexpr size_t WS_SSQ = 1 * MiB;
constexpr size_t WS_KMEAN = 3 * MiB;
constexpr size_t WS_NORMW = 3 * MiB + 768 * 1024;
constexpr size_t WS_WIN = 4 * MiB;
constexpr size_t WS_WOUT = 20 * MiB;
constexpr size_t WS_XN = 32 * MiB;
constexpr size_t WS_PROJ = 96 * MiB;
constexpr size_t WS_MIX = 352 * MiB;
constexpr size_t WS_OD = 416 * MiB;
constexpr size_t WS_END = 480 * MiB;
constexpr int CW_TMO = 0, CW_CODE = 1;
constexpr int CW_BAR = 4096;

constexpr int RING_OFF = 0, RING_BYTES = 131072;
constexpr int LDSCTL_OFF = RING_BYTES, MISC_OFF = LDSCTL_OFF + 320;
constexpr int LDS_BYTES = 147456;
static_assert(MISC_OFF + 128 <= LDS_BYTES, "LDS map");

struct Frame {
    LAS unsigned char* lds;
    volatile LAS unsigned* MISC;
    gu32* ctl;
    int wave;
    int vcu, G;
};
__device__ __forceinline__ int phase_tid(int wave) { int l; asm volatile("v_mbcnt_lo_u32_b32 %0, -1, 0\n\tv_mbcnt_hi_u32_b32 %0, -1, %0" : "=v"(l)); return (wave << 6) | l; }

__device__ __forceinline__ float wave_sum(float v) {
#pragma unroll
    for (int o = 1; o < 64; o <<= 1) v += __shfl_xor(v, o);
    return v;
}
template <bool PERMW>
__device__ __forceinline__ void p0_transpose_item(const float* W, int K, int N, bf16* WT, LAS float* scr, int item, int lane) {
    const int nblk = N / 32, kb = item / nblk, nb = item % nblk, k0 = 64 * kb, n0 = 32 * nb;
#pragma unroll 8
    for (int i = 0; i < 32; ++i) { const int kk = 2 * i + (lane >> 5); scr[kk * 33 + (lane & 31)] = W[(size_t)(k0 + kk) * N + n0 + (lane & 31)]; }
    LDS_WAIT(); asm volatile("" ::: "memory");
    const int c = lane & 7;
    int r0 = n0;
    if (PERMW) { const int pn = n0 >> 8, w = (n0 >> 6) & 3, bj = (n0 >> 5) & 1; r0 = (pn << 8) + (bj << 7) + (w << 5); }
#pragma unroll
    for (int j = 0; j < 4; ++j) { const int n = (lane >> 3) + 8 * j; const LAS float* s = scr + (8 * c) * 33 + n;
        v4u o; o.x = pk2(s[0 * 33], s[1 * 33]); o.y = pk2(s[2 * 33], s[3 * 33]); o.z = pk2(s[4 * 33], s[5 * 33]); o.w = pk2(s[6 * 33], s[7 * 33]);
        *(GAS v4u*)(WT + (size_t)(r0 + n) * K + k0 + 8 * c) = o; }
    LDS_WAIT(); asm volatile("" ::: "memory");
}

struct Args { const float* in[13]; float* out; unsigned char* ws; int ph_lo, ph_hi; };

__device__ __forceinline__ void p0_prologue(Frame& FF, const Args& args) {
    struct { int lane, wave, vcu, G; LAS unsigned char* lds; } F;
    { const int t = phase_tid(FF.wave); F.lane = t & 63; F.wave = FF.wave; F.vcu = FF.vcu; F.G = FF.G; F.lds = FF.lds; }
    LAS float* scr = (LAS float*)(F.lds + RING_OFF + F.wave * 16384);
    const int gw = F.vcu * NWAVES + F.wave, NGW = F.G * NWAVES;
    if (gw == 0) {
        float* nw = (float*)(args.ws + WS_NORMW);
#pragma unroll
        for (int l = 0; l < DEPTH; ++l) { nw[(l * 4 + 0) * 64 + F.lane] = args.in[3][l * 64 + F.lane]; nw[(l * 4 + 1) * 64 + F.lane] = args.in[4][l * 64 + F.lane];
            nw[(l * 4 + 2) * 64 + F.lane] = args.in[5][l * 64 + F.lane]; nw[(l * 4 + 3) * 64 + F.lane] = args.in[6][l * 64 + F.lane]; }
    }
    constexpr int I_IN = (D / 64) * (INW / 32), I_OUT = (D / 64) * (D / 32);
    constexpr int NITEMS = DEPTH * (I_IN + I_OUT);
    bf16* win = (bf16*)(args.ws + WS_WIN); bf16* wout = (bf16*)(args.ws + WS_WOUT);
    for (int it = gw; it < NITEMS; it += NGW) {
        int r = it;
        if (r < DEPTH * I_IN) { const int l = r / I_IN; r -= l * I_IN; p0_transpose_item<true>(args.in[2] + (size_t)l * D * INW, D, INW, win + (size_t)l * INW * D, scr, r, F.lane); continue; }
        r -= DEPTH * I_IN;
        { const int l = r / I_OUT; r -= l * I_OUT; p0_transpose_item<false>(args.in[12] + (size_t)l * D * D, D, D, wout + (size_t)l * D * D, scr, r, F.lane); }
    }
    const float* x = args.in[0]; const float* g0 = args.in[1];
    bf16* XN = (bf16*)(args.ws + WS_XN); float* ssq = (float*)(args.ws + WS_SSQ);
    f32x4 gv[4];
#pragma unroll
    for (int j = 0; j < 4; ++j) gv[j] = ((const GAS f32x4*)g0)[F.lane + 64 * j];
    for (int m = gw; m < M; m += NGW) {
        const GAS f32x4* xr = (const GAS f32x4*)(x + (size_t)m * D) + F.lane;
        f32x4 v[4]; float s = 0.f;
#pragma unroll
        for (int j = 0; j < 4; ++j) { v[j] = xr[64 * j]; s += (v[j].x * v[j].x + v[j].y * v[j].y) + (v[j].z * v[j].z + v[j].w * v[j].w); }
        s = wave_sum(s);
        GAS unsigned long long* o8 = (GAS unsigned long long*)(XN + (size_t)m * D) + F.lane;
#pragma unroll
        for (int j = 0; j < 4; ++j) { const f32x4 y = v[j] * gv[j]; o8[64 * j] = (unsigned long long)pk2(y.x, y.y) | ((unsigned long long)pk2(y.z, y.w) << 32); }
        if (F.lane < 16) ssq[(size_t)m * 16 + F.lane] = (F.lane == 0) ? s : 0.f;
    }
}

__device__ __forceinline__ void diff_combine(Frame& FF, const Args& args, int layer) {
    struct { int lane, wave, vcu, G; } F;
    { const int t = phase_tid(FF.wave); F.lane = t & 63; F.wave = FF.wave; F.vcu = FF.vcu; F.G = FF.G; }
    const int gw = F.vcu * NWAVES + F.wave, NGW = F.G * NWAVES;
    const float lam_init = (layer == 0) ? 0.2f : 0.35550906759096926f;
    const float* lq1 = args.in[7] + layer * 64; const float* lk1 = args.in[8] + layer * 64; const float* lq2 = args.in[9] + layer * 64; const float* lk2 = args.in[10] + layer * 64;
    const float s1 = wave_sum(lq1[F.lane] * lk1[F.lane]), s2 = wave_sum(lq2[F.lane] * lk2[F.lane]);
    const float lam = __expf(s1) - __expf(s2) + lam_init;
    const int h = F.lane >> 4, idx = F.lane & 15, vhalf = idx >> 3, dd = (idx & 7) * 8, c0 = vhalf * 64 + dd;
    const float* sub = args.in[11] + layer * 128 + c0;
    float sw[8];
#pragma unroll
    for (int e = 0; e < 8; ++e) sw[e] = sub[e] * (1.0f - lam_init);
    const bf16* OD = (const bf16*)(args.ws + WS_OD); const bf16* DG = (const bf16*)(args.ws + WS_PROJ) + (size_t)7 * M * 512; bf16* MIX = (bf16*)(args.ws + WS_MIX);
    for (int m = gw; m < M; m += NGW) {
        const v4u a = *(const GAS v4u*)(OD + (size_t)m * 1024 + ((h * 2 + 0) * 2 + vhalf) * 64 + dd);
        const v4u b = *(const GAS v4u*)(OD + (size_t)m * 1024 + ((h * 2 + 1) * 2 + vhalf) * 64 + dd);
        const v4u g = *(const GAS v4u*)(DG + (size_t)m * 512 + h * 128 + c0);
        float d[8], gg[8];
#define UNPK(dst, src, op) dst[0] op __uint_as_float(src.x << 16); dst[1] op __uint_as_float(src.x & 0xffff0000u); dst[2] op __uint_as_float(src.y << 16); dst[3] op __uint_as_float(src.y & 0xffff0000u); \
                           dst[4] op __uint_as_float(src.z << 16); dst[5] op __uint_as_float(src.z & 0xffff0000u); dst[6] op __uint_as_float(src.w << 16); dst[7] op __uint_as_float(src.w & 0xffff0000u);
        float o2[8];
        UNPK(d, a, =) UNPK(o2, b, =) UNPK(gg, g, =)
#undef UNPK
        float ss = 0.f;
#pragma unroll
        for (int e = 0; e < 8; ++e) { d[e] = d[e] - lam * o2[e]; ss += d[e] * d[e]; }
        ss += __shfl_xor(ss, 1); ss += __shfl_xor(ss, 2); ss += __shfl_xor(ss, 4); ss += __shfl_xor(ss, 8);
        const float rs = __builtin_amdgcn_rsqf(ss * (1.0f / 128.0f) + NORM_EPS);
        v4u o;
        o.x = pk2(d[0] * rs * sw[0] * gg[0], d[1] * rs * sw[1] * gg[1]); o.y = pk2(d[2] * rs * sw[2] * gg[2], d[3] * rs * sw[3] * gg[3]);
        o.z = pk2(d[4] * rs * sw[4] * gg[4], d[5] * rs * sw[5] * gg[5]); o.w = pk2(d[6] * rs * sw[6] * gg[6], d[7] * rs * sw[7] * gg[7]);
        *(GAS v4u*)(MIX + (size_t)m * 1024 + 512 + h * 128 + c0) = o;
    }
}

constexpr int ATT_PAIRS = BATCH * 24 * 8;
__device__ __forceinline__ bool attn_next(const Frame& F, const Args& args, int layer, int i, attn_body::UnitDesc& U) {
    const int ppc = (ATT_PAIRS + F.G - 1) / F.G;
    if (i >= 2 * ppc) return false;
    const int p = F.vcu * ppc + (i >> 1);
    if (p >= ATT_PAIRS) return false;
    const int bvh = p >> 3, s = p & 7, b = bvh / 24, vh = bvh % 24;
    U.qb = (i & 1) ? (15 - s) : s;
    const attn_body::bf16* proj = (const attn_body::bf16*)(args.ws + WS_PROJ);
    const size_t TS = (size_t)M * 512, rb = (size_t)b * SEQ;
    if (vh < 8) {
        U.Q = proj + 0 * TS + rb * 512 + vh * 64; U.K = proj + 1 * TS + rb * 512 + vh * 64; U.V = proj + 2 * TS + rb * 512 + vh * 64; U.G = proj + 3 * TS + rb * 512 + vh * 64;
        U.O = (attn_body::bf16*)(args.ws + WS_MIX) + rb * 1024 + vh * 64;
        U.KM = (const float*)(args.ws + WS_KMEAN) + (size_t)(b * 8 + vh) * 16 * 2 * 64;
        U.a2 = 1.4426950408889634f * __builtin_amdgcn_exp2f(-(float)(vh + 1));
    } else {
        const int dv = vh - 8, hc = dv >> 1, vhalf = dv & 1, h = hc >> 1;
        U.Q = proj + 4 * TS + rb * 512 + hc * 64; U.K = proj + 5 * TS + rb * 512 + hc * 64; U.V = proj + 6 * TS + rb * 512 + h * 128 + vhalf * 64; U.G = nullptr;
        U.O = (attn_body::bf16*)(args.ws + WS_OD) + rb * 1024 + dv * 64;
        U.KM = nullptr;
        U.a2 = 1.4426950408889634f * __builtin_amdgcn_exp2f(-2.0f * (float)(h + 1));
    }
    return true;
}

__global__ void __launch_bounds__(NWAVES * 64, 2) mk_fwd(Args args) {
    extern __shared__ __attribute__((aligned(16))) unsigned char lds[];
    Frame F;
    F.lds = (LAS unsigned char*)lds;
    F.MISC = (volatile LAS unsigned*)(F.lds + MISC_OFF);
    F.wave = __builtin_amdgcn_readfirstlane((int)threadIdx.x >> 6);
    F.G = gridDim.x; { const int bx = blockIdx.x; F.vcu = (F.G % 8 == 0) ? (bx % 8) * (F.G / 8) + bx / 8 : bx; }
    unsigned char* ws = args.ws;
    F.ctl = (gu32*)(ws + WS_CTL);
    for (int u = threadIdx.x; u < (LDS_BYTES - LDSCTL_OFF) / 4; u += NWAVES * 64) ((LAS unsigned*)(F.lds + LDSCTL_OFF))[u] = 0u;
    __syncthreads();
    XcdBarrier bar; bar.bar = (unsigned*)(F.ctl + CW_BAR); bar.x = 0; bar.st = nullptr;
    if (!MK_PER_PHASE) bar = xcd_barrier_post((unsigned*)(F.ctl + CW_BAR), F.MISC + 8, (int)threadIdx.x);
#define GRID_BAR() do { if (MK_PER_PHASE) { if (phase_tid(F.wave) == 0) __hip_atomic_store(F.ctl + CW_TMO, 0xBADBA0u, RLX_AGENT); } else { xcd_barrier(bar, phase_tid(F.wave)); } } while (0)
    const int lo = args.ph_lo, hi = args.ph_hi;
#define IN(k) (lo <= (k) && (k) < hi)
#define BOTH(k) (IN(k) && IN((k) + 1))

#ifndef NO_P0
    if (IN(0)) { p0_prologue(F, args); if (BOTH(0)) GRID_BAR(); }
#endif

    for (int layer = 0; layer < DEPTH; ++layer) {
        const int pb = 1 + 4 * layer;
        if (IN(pb)) {
            pg8::Gemm g{(const pg8::bf16_t*)(ws + WS_XN), (const pg8::bf16_t*)(ws + WS_WIN) + (size_t)layer * INW * D, M, INW, D};
            pg8::StaticOrder S; S.init(M, INW, F.G, (int)blockIdx.x);
            pg8::EpiProj E{(pg8::bf16_t*)(ws + WS_PROJ), (const float*)(ws + WS_SSQ), (const float*)(ws + WS_NORMW) + layer * 256, (float*)(ws + WS_KMEAN)};
#ifndef NO_PROJ
            pg8::gemm_phase<pg8::EpiProj, pg8::StaticOrder, PG8_ALIGN, PG8_SP2>(F.lds + RING_OFF, g, S, E, phase_tid(F.wave));
#endif
            if (BOTH(pb)) GRID_BAR();
        }
        if (IN(pb + 1)) {
            attn_body::UnitDesc U;
#ifndef NO_ATTN
            const int atid = phase_tid(F.wave);
            for (int i = 0; attn_next(F, args, layer, i, U); ++i) attn_body::attn_unit<8>(U, (char*)lds + RING_OFF, atid);
#endif
            if (BOTH(pb + 1)) GRID_BAR();
        }
#ifndef NO_COMB
        if (IN(pb + 2)) { diff_combine(F, args, layer); if (BOTH(pb + 2)) GRID_BAR(); }
#endif
        if (IN(pb + 3)) {
            const int last = (layer == DEPTH - 1);
            pg8::Gemm g{(const pg8::bf16_t*)(ws + WS_MIX), (const pg8::bf16_t*)(ws + WS_WOUT) + (size_t)layer * D * D, M, D, D};
            pg8::StaticOrder S; S.init(M, D, F.G, (int)blockIdx.x);
            pg8::EpiOut E{layer == 0 ? args.in[0] : (const float*)args.out, args.out, (pg8::bf16_t*)(ws + WS_XN), args.in[1] + (last ? 0 : (layer + 1) * D), (float*)(ws + WS_SSQ), last};
#ifndef NO_OUT
            pg8::gemm_phase<pg8::EpiOut, pg8::StaticOrder, PG8_ALIGN, PG8_SP2>(F.lds + RING_OFF, g, S, E, phase_tid(F.wave));
#endif
            if (BOTH(pb + 3)) GRID_BAR();
        }
    }
#undef IN
#undef BOTH
}

extern "C" void kernel_launch(void* const* d_in, const int* in_sizes, int n_in, void* d_out, int out_size, void* d_ws, size_t ws_size, hipStream_t stream) {
    static int grid = 0;
    if (grid == 0) {
        if (n_in != 13 || in_sizes[0] != M * D || out_size != M * D || ws_size < WS_END) { fprintf(stderr, "kernel_launch: unexpected shapes (n_in %d in0 %d out %d ws %zu); nothing launched\n", n_in, n_in > 0 ? in_sizes[0] : -1, out_size, ws_size); grid = -1; return; }
        int dev = 0, cus = 0, per_cu = 0;
        if (hipGetDevice(&dev) != hipSuccess || hipDeviceGetAttribute(&cus, hipDeviceAttributeMultiprocessorCount, dev) != hipSuccess) { grid = -1; return; }
        if (hipFuncSetAttribute((const void*)mk_fwd, hipFuncAttributeMaxDynamicSharedMemorySize, LDS_BYTES) != hipSuccess) { fprintf(stderr, "kernel_launch: hipFuncSetAttribute failed\n"); grid = -1; return; }
        if (hipOccupancyMaxActiveBlocksPerMultiprocessor(&per_cu, (const void*)mk_fwd, NWAVES * 64, LDS_BYTES) != hipSuccess || per_cu < 1)
            fprintf(stderr, "kernel_launch: note: occupancy query reports %d workgroups per CU\n", per_cu);
        (void)hipGetLastError();
        grid = cus;
    }
    if (grid < 0) return;
    if (hipMemsetAsync((char*)d_ws + WS_CTL, 0, CTL_ZERO_BYTES, stream) != hipSuccess) return;
    Args a{};
    for (int i = 0; i < 13; ++i) a.in[i] = (const float*)d_in[i];
    a.out = (float*)d_out; a.ws = (unsigned char*)d_ws;
#if MK_PER_PHASE
    for (int p = 0; p < N_PHASES; ++p) { a.ph_lo = p; a.ph_hi = p + 1; hipLaunchKernelGGL(mk_fwd, dim3(grid), dim3(NWAVES * 64), LDS_BYTES, stream, a); }
#else
    a.ph_lo = 0; a.ph_hi = N_PHASES;
    hipLaunchKernelGGL(mk_fwd, dim3(grid), dim3(NWAVES * 64), LDS_BYTES, stream, a);
#endif
    const hipError_t le = hipPeekAtLastError();
    if (le != hipSuccess) fprintf(stderr, "kernel_launch: launch failed: %s (grid %d)\n", hipGetErrorName(le), grid);
}
```

```cpp
#include <hip/hip_runtime.h>
#include <cstdio>
#include <cstdint>
namespace pg8 {
#define PG8_LAS __attribute__((address_space(3)))
typedef unsigned short bf16_t;
typedef short bf16x8 __attribute__((ext_vector_type(8)));
typedef float f32x4 __attribute__((ext_vector_type(4)));
typedef unsigned u32x4 __attribute__((ext_vector_type(4)));
constexpr int BM = 256, BK = 64, HALF = 128, HTB = HALF * BK * 2  , STAGE_BYTES = 8 * HTB, NXCD = 8, WGM = 8;

__host__ __device__ __forceinline__ int lds_byte(int r, int c) { const int st = (r >> 4) * 2 + (c >> 5), rr = r & 15, cc = c & 31, ob = rr * 64 + cc * 2; return st * 1024 + (ob ^ (((ob >> 9) & 1) << 5)); }
__host__ __device__ __forceinline__ void stage_rc(int b, int& R, int& C) { const int st = b / 1024, sb = b % 1024, swz = sb ^ (((sb >> 9) & 1) << 5); R = (st >> 1) * 16 + swz / 64; C = (st & 1) * 32 + (swz % 64) / 2; }
__host__ __device__ __forceinline__ int perm32(int rho) { const int n = rho >> 4, i = rho & 15; return 8 * (i >> 2) + 4 * n + (i & 3); }

struct Unit { int pm, pn; };
struct Gemm { const bf16_t* A; const bf16_t* Bt; int M, N, K; };

struct StaticOrder {
    int nM, nN, nwg, G, c;
    __host__ __device__ void init(int M, int N, int G_, int c_) { nM = M / BM; nN = N / BM; nwg = nM * nN; G = G_; c = c_; }
    __host__ __device__ bool next(int i, Unit& u) const {
        const long L = (long)i * G + c; if (L >= nwg) return false;
        int wgid = (int)L; { const int q = nwg / NXCD, r = nwg % NXCD, xcd = wgid % NXCD, off = wgid / NXCD; wgid = (xcd < r ? xcd * (q + 1) : r * (q + 1) + (xcd - r) * q) + off; }
        const int nig = WGM * nN, gid = wgid / nig, fm = gid * WGM, gsz = (nM - fm) < WGM ? (nM - fm) : WGM;
        u.pm = fm + ((wgid % nig) % gsz); u.pn = (wgid % nig) / gsz; return true;
    }
    __device__ __forceinline__ void a_ready(const Unit&) const {}
    __device__ __forceinline__ void done(const Unit&) const {}
};

struct SingleOrder {
    Unit u;
    __device__ __forceinline__ bool next(int i, Unit& o) const { if (i != 0) return false; o = u; return true; }
    __device__ __forceinline__ void a_ready(const Unit&) const {}
    __device__ __forceinline__ void done(const Unit&) const {}
};

__device__ __forceinline__ unsigned cvt_pk_bf16(float lo, float hi) { unsigned r; asm volatile("v_cvt_pk_bf16_f32 %0, %1, %2" : "=v"(r) : "v"(lo), "v"(hi)); return r; }
typedef float f32x2 __attribute__((ext_vector_type(2)));
#ifndef WT_STORES
#define WT_STORES 0
#endif
#if WT_STORES
#define ST16_WT(p, v) asm volatile("global_store_dwordx4 %0, %1, off sc1\n\ts_nop 1" :: "v"(p), "v"(v) : "memory")
#else
#define ST16_WT(p, v) (*(u32x4*)(p) = (v))
#endif
constexpr int PM_ROWS = 32768;
constexpr float C2Q = 0.125f * 1.4426950408889634f;
struct EpiProj {
    static constexpr bool PERM = true, AFTER_DRAIN = false;
    bf16_t* proj;
    const float* ssq;
    const float* normw;
    float* kmean;
    int nrep;
#ifdef PROBE_EPI_T
    static constexpr bool TIMED = (PROBE_EPI_T == 1); volatile PG8_LAS unsigned* tacc;
#endif
    static constexpr int NST0 = 16, NST1 = 20;
    __device__ __forceinline__ int nstores(const Unit& u) const { return (u.pn >> 1) == 1 ? NST1 : NST0; }
    static __device__ __forceinline__ float sum_fq(float x) {
        auto a = __builtin_amdgcn_permlane16_swap(__float_as_uint(x), __float_as_uint(x), false, false); x = __uint_as_float(a[0]) + __uint_as_float(a[1]);
        auto b = __builtin_amdgcn_permlane32_swap(__float_as_uint(x), __float_as_uint(x), false, false); return __uint_as_float(b[0]) + __uint_as_float(b[1]); }
    static __device__ __forceinline__ float sum_fr(float x) {
        x += __builtin_bit_cast(float, __builtin_amdgcn_update_dpp(0, __builtin_bit_cast(int, x), 0xB1, 0xF, 0xF, true));
        x += __builtin_bit_cast(float, __builtin_amdgcn_update_dpp(0, __builtin_bit_cast(int, x), 0x4E, 0xF, 0xF, true));
        x += __builtin_bit_cast(float, __builtin_amdgcn_update_dpp(0, __builtin_bit_cast(int, x), 0x141, 0xF, 0xF, true));
        x += __builtin_bit_cast(float, __builtin_amdgcn_update_dpp(0, __builtin_bit_cast(int, x), 0x140, 0xF, 0xF, true));
        return x; }
    __device__ __forceinline__ void rows_qk(const bool KM, const f32x4 (&acc)[2][2][4][2], bf16_t* base, const float (&rinv)[8], const f32x4 (&wv)[2][2], const Unit& u, int row0, int col0, int wr, int wc, int fr, int fq) const {
        f32x4 ks[2][2];
#pragma unroll
        for (int bj = 0; bj < 2; ++bj)
#pragma unroll
            for (int n = 0; n < 2; ++n) ks[bj][n] = (f32x4){0.f, 0.f, 0.f, 0.f};
#pragma unroll
        for (int ai = 0; ai < 2; ++ai)
#pragma unroll
            for (int m = 0; m < 4; ++m) {
                const int row = row0 + ai * HALF + m * 16;
                f32x2 s2 = {0.f, 0.f};
#pragma unroll
                for (int bj = 0; bj < 2; ++bj)
#pragma unroll
                    for (int n = 0; n < 2; ++n) { const f32x4 a = acc[ai][bj][m][n]; const f32x2 lo = {a[0], a[1]}, hi2 = {a[2], a[3]};
                        s2 = __builtin_elementwise_fma(lo, lo, s2); s2 = __builtin_elementwise_fma(hi2, hi2, s2); }
                const float ss = sum_fq(s2[0] + s2[1]);
                const float r = rinv[ai * 4 + m];
                const float s1 = r * __builtin_amdgcn_rsqf(ss * (r * r) * (1.0f / 64.0f) + 1e-6f);
                f32x4 v[2][2];
#pragma unroll
                for (int bj = 0; bj < 2; ++bj)
#pragma unroll
                    for (int n = 0; n < 2; ++n) v[bj][n] = acc[ai][bj][m][n] * s1 * wv[bj][n];
                if (KM) { asm volatile("");
#pragma unroll
                    for (int bj = 0; bj < 2; ++bj)
#pragma unroll
                        for (int n = 0; n < 2; ++n) ks[bj][n] += v[bj][n]; }
                bf16_t* rowp = base + (size_t)row * 512 + col0;
#pragma unroll
                for (int bj = 0; bj < 2; ++bj) { u32x4 w4; w4.x = cvt_pk_bf16(v[bj][0][0], v[bj][0][1]); w4.y = cvt_pk_bf16(v[bj][0][2], v[bj][0][3]); w4.z = cvt_pk_bf16(v[bj][1][0], v[bj][1][1]); w4.w = cvt_pk_bf16(v[bj][1][2], v[bj][1][3]);
                    ST16_WT(rowp + 32 * bj, w4); }
                asm volatile("" ::: "memory"); __builtin_amdgcn_sched_barrier(0);
            }
        if (KM) {
#pragma unroll
            for (int bj = 0; bj < 2; ++bj)
#pragma unroll
                for (int n = 0; n < 2; ++n)
#pragma unroll
                    for (int j = 0; j < 4; ++j) ks[bj][n][j] = sum_fr(ks[bj][n][j]);
            if (fr == 0) {
                const int b = u.pm >> 4, blk = u.pm & 15, h = (u.pn & 1) * 4 + wc;
                float* kp = kmean + ((size_t)((b * 8 + h) * 16 + blk) * 2 + wr) * 64 + 8 * fq;
#pragma unroll
                for (int bj = 0; bj < 2; ++bj)
#pragma unroll
                    for (int n = 0; n < 2; ++n) *(f32x4*)(kp + 32 * bj + 4 * n) = ks[bj][n];
            }
        }
    }
    struct Pre {}; struct State { f32x4 ra, rb; int pm; };
    __device__ __forceinline__ void begin(State& st) const { st.pm = -1; st.ra = (f32x4){0.f, 0.f, 0.f, 0.f}; st.rb = st.ra; }
    __device__ __forceinline__ void pre_load(Pre&, const Unit&, int, int, int, int) const {}
    __device__ __forceinline__ void pre_none(Pre&) const {}
    __device__ __forceinline__ void pre_apply(f32x4 (&acc)[2][2][4][2], const Pre&) const {
#pragma unroll
        for (int a = 0; a < 2; ++a)
#pragma unroll
            for (int b = 0; b < 2; ++b)
#pragma unroll
                for (int m = 0; m < 4; ++m)
#pragma unroll
                    for (int n = 0; n < 2; ++n) acc[a][b][m][n] = (f32x4){0.f, 0.f, 0.f, 0.f};
    }
    __device__ __forceinline__ void operator()(const f32x4 (&acc)[2][2][4][2], const Unit& u, int wr, int wc, int fr, int fq, State& st) const {
        asm volatile("" : "+v"(fr), "+v"(fq));
        const int mode = u.pn >> 1;
        bf16_t* base = proj + (size_t)mode * PM_ROWS * 512;
        const int col0 = (u.pn & 1) * 256 + wc * 64 + 8 * fq;
        const int row0 = u.pm * BM + wr * 64 + fr;
        const bool isqk = (mode & 2) == 0, isg = (mode & 3) == 3, iskm = (mode == 1);
        f32x4 wv[2][2];
        if (isqk) {
            const float* w = normw + (((mode >> 2) * 2 + (mode & 1)) * 64);
            const float sc = (mode & 1) ? 1.0f : C2Q;
#pragma unroll
            for (int bj = 0; bj < 2; ++bj)
#pragma unroll
                for (int n = 0; n < 2; ++n) wv[bj][n] = *(const f32x4*)(w + 32 * bj + 8 * fq + 4 * n) * sc;
        }
        float rinv[8];
        if (st.pm != u.pm) { st.pm = u.pm; f32x4 sq[8];
#pragma unroll
          for (int q = 0; q < 8; ++q) sq[q] = *(const f32x4*)(ssq + (size_t)(row0 + (q >> 2) * HALF + (q & 3) * 16) * 16 + 4 * fq);
#pragma unroll
          for (int q = 0; q < 8; ++q) { float tot = (sq[q][0] + sq[q][1]) + (sq[q][2] + sq[q][3]); tot = sum_fq(tot); rinv[q] = __builtin_amdgcn_rsqf(tot * (1.0f / 1024.0f) + 1e-6f); }
          st.ra = (f32x4){rinv[0], rinv[1], rinv[2], rinv[3]}; st.rb = (f32x4){rinv[4], rinv[5], rinv[6], rinv[7]}; }
        else {
#pragma unroll
          for (int q = 0; q < 4; ++q) { rinv[q] = st.ra[q]; rinv[4 + q] = st.rb[q]; } }
        if (isqk) {
            rows_qk(iskm, acc, base, rinv, wv, u, row0, col0, wr, wc, fr, fq);
        } else {
#pragma unroll
            for (int ai = 0; ai < 2; ++ai)
#pragma unroll
                for (int m = 0; m < 4; ++m) {
                    const int row = row0 + ai * HALF + m * 16;
                    f32x4 v[2][2];
#pragma unroll
                    for (int bj = 0; bj < 2; ++bj)
#pragma unroll
                        for (int n = 0; n < 2; ++n) v[bj][n] = acc[ai][bj][m][n] * rinv[ai * 4 + m];
                    if (isg) {
#pragma unroll
                        for (int bj = 0; bj < 2; ++bj)
#pragma unroll
                            for (int n = 0; n < 2; ++n)
#pragma unroll
                                for (int j = 0; j < 4; ++j) { const float x = v[bj][n][j]; v[bj][n][j] = x * __builtin_amdgcn_rcpf(1.0f + __builtin_amdgcn_exp2f(-1.4426950408889634f * x)); }
                    }
                    bf16_t* rowp = base + (size_t)row * 512 + col0;
#pragma unroll
                    for (int bj = 0; bj < 2; ++bj) { u32x4 w4; w4.x = cvt_pk_bf16(v[bj][0][0], v[bj][0][1]); w4.y = cvt_pk_bf16(v[bj][0][2], v[bj][0][3]); w4.z = cvt_pk_bf16(v[bj][1][0], v[bj][1][1]); w4.w = cvt_pk_bf16(v[bj][1][2], v[bj][1][3]);
                        ST16_WT(rowp + 32 * bj, w4); }
                    asm volatile("" ::: "memory");
                }
        }
    }
};
struct EpiOut {
    static constexpr bool PERM = true, AFTER_DRAIN = false;
    bf16_t* xn; float* out; float* ssq; int last;
#ifdef PROBE_EPI_T
    static constexpr bool TIMED = (PROBE_EPI_T == 2); volatile PG8_LAS unsigned* tacc;
#endif
#ifdef PROBE_TIME
    const unsigned* busy;
    volatile PG8_LAS unsigned* stamps;
#endif
    static constexpr int NST0 = 24, NST1 = 32;
    __device__ __forceinline__ int nstores(const Unit&) const { return last ? NST1 : NST0; }
    struct Pre { u32x4 bs[2][4][2]; }; struct State {};
    __device__ __forceinline__ void begin(State&) const {}
    __device__ __forceinline__ void pre_load(Pre& p, const Unit& u, int wr, int wc, int fr, int fq) const {
        const int col0 = u.pn * BM + wc * 32 + 8 * fq;
#pragma unroll
        for (int ai = 0; ai < 2; ++ai)
#pragma unroll
            for (int m = 0; m < 4; ++m)
#pragma unroll
                for (int bj = 0; bj < 2; ++bj) p.bs[ai][m][bj] = *(const u32x4*)(xn + (size_t)(u.pm * BM + ai * HALF + wr * 64 + m * 16 + fr) * 1024 + col0 + bj * HALF);
    }
    __device__ __forceinline__ void pre_none(Pre& p) const {
#pragma unroll
        for (int ai = 0; ai < 2; ++ai)
#pragma unroll
            for (int m = 0; m < 4; ++m)
#pragma unroll
                for (int bj = 0; bj < 2; ++bj) p.bs[ai][m][bj] = (u32x4){0u, 0u, 0u, 0u};
    }
    __device__ __forceinline__ void pre_apply(f32x4 (&acc)[2][2][4][2], const Pre& p) const {
#pragma unroll
        for (int ai = 0; ai < 2; ++ai)
#pragma unroll
            for (int m = 0; m < 4; ++m)
#pragma unroll
                for (int bj = 0; bj < 2; ++bj) { const u32x4 b = p.bs[ai][m][bj];
                    acc[ai][bj][m][0] = (f32x4){__uint_as_float(b.x << 16), __uint_as_float(b.x & 0xffff0000u), __uint_as_float(b.y << 16), __uint_as_float(b.y & 0xffff0000u)};
                    acc[ai][bj][m][1] = (f32x4){__uint_as_float(b.z << 16), __uint_as_float(b.z & 0xffff0000u), __uint_as_float(b.w << 16), __uint_as_float(b.w & 0xffff0000u)}; }
    }
    __device__ __forceinline__ void operator()(const f32x4 (&acc)[2][2][4][2], const Unit& u, int wr, int wc, int fr, int fq, State&) const {
        const int col0 = u.pn * BM + wc * 32 + 8 * fq;
#pragma unroll
        for (int ai = 0; ai < 2; ++ai)
#pragma unroll
            for (int m = 0; m < 4; ++m) {
                const int row = u.pm * BM + ai * HALF + wr * 64 + m * 16 + fr; const size_t off = (size_t)row * 1024 + col0;
                float ss = 0.f;
#pragma unroll
                for (int bj = 0; bj < 2; ++bj) {
                    f32x4 o0 = acc[ai][bj][m][0], o1 = acc[ai][bj][m][1];
#ifdef PROBE_TIME
                    if (last && row == 0 && col0 == 0 && bj == 0) {
                        const unsigned now = (unsigned)__builtin_amdgcn_s_memrealtime(); const unsigned t0 = stamps[0], ta = stamps[PROBE_TIME], tb = stamps[PROBE_TIME + 1];
#if defined(PROBE_BUSY)
                        { const unsigned* bt = busy; unsigned mx = 0u, mn = 0xffffffffu; float sm = 0.f;
                          for (int i = 0; i < 256; ++i) { const unsigned v = bt[i]; mx = v > mx ? v : mx; mn = v < mn ? v : mn; sm += (float)v; }
                          const float val = (PROBE_BUSY == 0) ? sm * (1.0f / 256.0f) : (PROBE_BUSY == 1 ? (float)mx : (float)mn);
                          const float f = val / (float)(now - t0); o0[0] += 51.3f * sqrtf(f); } }
#elif defined(PROBE_ATT_T)
                        const float f = (float)stamps[20 + PROBE_ATT_T] / (float)(now - t0); o0[0] += 51.3f * sqrtf(f); }
#elif defined(PROBE_EPI_T)
                        const float f = (float)stamps[20] / (float)(now - t0); o0[0] += 51.3f * sqrtf(f); }
#else
                        const float f = (float)(tb - ta) / (float)(now - t0); o0[0] += 51.3f * sqrtf(f); }
#endif
#endif
                    if (last) { *(f32x4*)(out + off + bj * HALF) = o0; *(f32x4*)(out + off + bj * HALF + 4) = o1; }
                    else { ss += ((o0[0] * o0[0] + o0[1] * o0[1]) + (o0[2] * o0[2] + o0[3] * o0[3])) + ((o1[0] * o1[0] + o1[1] * o1[1]) + (o1[2] * o1[2] + o1[3] * o1[3]));
                        u32x4 w; w.x = cvt_pk_bf16(o0[0], o0[1]); w.y = cvt_pk_bf16(o0[2], o0[3]); w.z = cvt_pk_bf16(o1[0], o1[1]); w.w = cvt_pk_bf16(o1[2], o1[3]);
                        *(u32x4*)(xn + off + bj * HALF) = w; }
                }
                if (!last) { ss = EpiProj::sum_fq(ss); if (fq == 0) ssq[(size_t)row * 16 + u.pn * 4 + wc] = ss; }
            }
    }
};
template <class Epi, class Sched, bool ALIGN_EPI = false, bool SP2 = false>
__device__ __forceinline__ void gemm_phase(PG8_LAS unsigned char* lds, const Gemm g, const Sched& S, const Epi& E, const int tid) {
    const int wid = __builtin_amdgcn_readfirstlane(tid >> 6), lane = tid & 63, wr = wid >> 2, wc = wid & 3, fr = lane & 15, fq = lane >> 4;
    constexpr int K = 1024, nt = K / BK;
    unsigned voffA[2], voffB[2];
#pragma unroll
    for (int i = 0; i < 2; ++i) { int R, C; stage_rc(tid * 16 + i * 8192, R, C); const int Rb = Epi::PERM ? ((R & ~31) + perm32(R & 31)) : R;
        voffA[i] = (unsigned)(R * K + C) * 2u; voffB[i] = (unsigned)(Rb * K + C) * 2u; }
    constexpr size_t kstep = (size_t)(BK * 2);
    constexpr size_t hstep = (size_t)HALF * K * 2;
    constexpr size_t tstep = 2 * hstep;
    const unsigned ldsw = (unsigned)wid * 1024u;
    const int aoff = lds_byte(wr * 64 + fr, fq * 8), boff = lds_byte(wc * 32 + fr, fq * 8);
#define PG8_SA(b, h) (((b) * 2 + (h)) * HTB)
#define PG8_SB(b, h) ((4 + (b) * 2 + (h)) * HTB)
#define PG8_STAGE(bufoff, gbase, voff) do { _Pragma("unroll") for (int _i = 0; _i < 2; ++_i) \
        __builtin_amdgcn_global_load_lds((const unsigned*)((const char*)(gbase) + (voff)[_i]), (PG8_LAS unsigned*)(lds + (bufoff) + ldsw + _i * 8192), 16, 0, 0); } while (0)
#define PG8_LDA(dst, b, h) do { _Pragma("unroll") for (int m = 0; m < 4; ++m) _Pragma("unroll") for (int k = 0; k < 2; ++k) dst[m][k] = *(const PG8_LAS bf16x8*)(lds + PG8_SA(b, h) + aoff + m * 2048 + k * 1024); } while (0)
#define PG8_LDB(dst, b, h) do { _Pragma("unroll") for (int n = 0; n < 2; ++n) _Pragma("unroll") for (int k = 0; k < 2; ++k) dst[n][k] = *(const PG8_LAS bf16x8*)(lds + PG8_SB(b, h) + boff + n * 2048 + k * 1024); } while (0)
#define PG8_MMA(ai, bj, At, Bt) do { __builtin_amdgcn_s_setprio(1); _Pragma("unroll") for (int m = 0; m < 4; ++m) _Pragma("unroll") for (int n = 0; n < 2; ++n) _Pragma("unroll") for (int k = 0; k < 2; ++k) \
        acc[ai][bj][m][n] = __builtin_amdgcn_mfma_f32_16x16x32_bf16(Bt[n][k], At[m][k], acc[ai][bj][m][n], 0, 0, 0); __builtin_amdgcn_s_setprio(0); } while (0)
#define PG8_WAIT_V(n) asm volatile("s_waitcnt vmcnt(" #n ")" ::: "memory")
#define PG8_WAIT_L(n) asm volatile("s_waitcnt lgkmcnt(" #n ")" ::: "memory")
#define PG8_BAR __builtin_amdgcn_s_barrier()
#define PG8_SCHED __builtin_amdgcn_sched_barrier(0)
#define PG8_WAIT_V8X do { if (__builtin_expect(xs != 0, 0)) { if (xs == Epi::NST0) PG8_WAIT_VN(8 + Epi::NST0); else PG8_WAIT_VN(8 + Epi::NST1); } else PG8_WAIT_V(8); } while (0)
#define PG8_WAIT_VN(n) asm volatile("s_waitcnt vmcnt(%0)" :: "n"(n) : "memory")
    Unit cur, nxt; int ui = 0; int xs = 0;
    if (!S.next(0, cur)) return;
    f32x4 acc[2][2][4][2];
    typename Epi::Pre pre; typename Epi::State est; E.begin(est);
    E.pre_load(pre, cur, wr, wc, fr, fq);
    bf16x8 At[4][2], B0[2][2], B1[2][2];
    const char* cA = (const char*)g.A + (size_t)cur.pm * tstep; const char* cB = (const char*)g.Bt + (size_t)cur.pn * tstep;
    S.a_ready(cur);
    if constexpr (SP2) {
        PG8_STAGE(PG8_SB(0, 0), cB, voffB); PG8_STAGE(PG8_SB(0, 1), cB + hstep, voffB); PG8_STAGE(PG8_SA(0, 0), cA, voffA); PG8_STAGE(PG8_SA(0, 1), cA + hstep, voffA);
        if (wr == 1) PG8_BAR;
        PG8_WAIT_V(2); PG8_BAR;
        PG8_STAGE(PG8_SB(1, 0), cB + kstep, voffB); PG8_STAGE(PG8_SA(1, 0), cA + kstep, voffA); PG8_STAGE(PG8_SB(1, 1), cB + hstep + kstep, voffB);
        PG8_WAIT_V(6); PG8_BAR;
    } else {
        PG8_STAGE(PG8_SB(0, 0), cB, voffB); PG8_STAGE(PG8_SA(0, 0), cA, voffA); PG8_STAGE(PG8_SB(0, 1), cB + hstep, voffB); PG8_STAGE(PG8_SA(0, 1), cA + hstep, voffA);
        if (wr == 1) PG8_BAR;
        PG8_WAIT_V(4); PG8_BAR;
        PG8_STAGE(PG8_SB(1, 0), cB + kstep, voffB); PG8_STAGE(PG8_SA(1, 0), cA + kstep, voffA); PG8_STAGE(PG8_SB(1, 1), cB + hstep + kstep, voffB);
        PG8_WAIT_V(6); PG8_BAR;
    }
    E.pre_apply(acc, pre);
    for (;;) {
        const bool has_next = S.next(ui + 1, nxt);
        const char* nA = has_next ? (const char*)g.A + (size_t)nxt.pm * tstep : cA; const char* nB = has_next ? (const char*)g.Bt + (size_t)nxt.pn * tstep : cB;
#pragma unroll 1
        for (int t = 0; t < nt; t += 2) {
            const bool last = (t == nt - 2);
            const char* a1 = cA + (size_t)(t + 1) * kstep;
            const char* a2 = last ? nA : cA + (size_t)(t + 2) * kstep; const char* b2 = last ? nB : cB + (size_t)(t + 2) * kstep;
            const char* a3 = a2 + kstep; const char* b3 = b2 + kstep;
            if (last && has_next) S.a_ready(nxt);
            if constexpr (SP2) {
            PG8_LDB(B0, 0, 0); PG8_LDB(B1, 0, 1); PG8_SCHED; PG8_LDA(At, 0, 0); if (xs == 0) PG8_STAGE(PG8_SA(1, 1), a1 + hstep, voffA);
            PG8_WAIT_V8X; PG8_WAIT_L(0); PG8_BAR; PG8_MMA(0, 0, At, B0); PG8_MMA(0, 1, At, B1); PG8_BAR; PG8_SCHED;
            PG8_LDA(At, 0, 1); PG8_STAGE(PG8_SB(0, 0), b2, voffB); PG8_STAGE(PG8_SB(0, 1), b2 + hstep, voffB); PG8_STAGE(PG8_SA(0, 0), a2, voffA);
            PG8_WAIT_V8X; PG8_WAIT_L(0); PG8_BAR; PG8_MMA(1, 0, At, B0); PG8_MMA(1, 1, At, B1); PG8_BAR; PG8_SCHED;
            PG8_LDB(B0, 1, 0); PG8_LDB(B1, 1, 1); PG8_SCHED; PG8_LDA(At, 1, 0); PG8_STAGE(PG8_SA(0, 1), a2 + hstep, voffA);
            PG8_WAIT_V8X; PG8_WAIT_L(0); PG8_BAR; PG8_MMA(0, 0, At, B0); PG8_MMA(0, 1, At, B1); PG8_BAR; PG8_SCHED; xs = 0;
            PG8_LDA(At, 1, 1); PG8_STAGE(PG8_SB(1, 0), b3, voffB); PG8_STAGE(PG8_SB(1, 1), b3 + hstep, voffB); PG8_STAGE(PG8_SA(1, 0), a3, voffA);
            PG8_WAIT_V(8); PG8_WAIT_L(0); PG8_BAR; PG8_MMA(1, 0, At, B0); PG8_MMA(1, 1, At, B1); PG8_BAR; PG8_SCHED;
            } else {
            PG8_LDB(B0, 0, 0); PG8_SCHED; PG8_LDA(At, 0, 0); PG8_STAGE(PG8_SA(1, 1), a1 + hstep, voffA);
            PG8_WAIT_L(8); PG8_BAR; PG8_WAIT_L(0); PG8_MMA(0, 0, At, B0); PG8_BAR; PG8_SCHED;
            PG8_LDB(B1, 0, 1); PG8_STAGE(PG8_SB(0, 0), b2, voffB);
            PG8_BAR; PG8_WAIT_L(0); PG8_MMA(0, 1, At, B1); PG8_BAR;
            PG8_LDA(At, 0, 1); PG8_STAGE(PG8_SA(0, 0), a2, voffA);
            PG8_BAR; PG8_WAIT_L(0); PG8_MMA(1, 0, At, B0); PG8_BAR; PG8_SCHED;
            PG8_STAGE(PG8_SB(0, 1), b2 + hstep, voffB);
            PG8_WAIT_V(6); PG8_BAR; PG8_MMA(1, 1, At, B1); PG8_BAR;
            PG8_LDB(B0, 1, 0); PG8_SCHED; PG8_LDA(At, 1, 0); PG8_STAGE(PG8_SA(0, 1), a2 + hstep, voffA);
            PG8_WAIT_L(8); PG8_BAR; PG8_WAIT_L(0); PG8_MMA(0, 0, At, B0); PG8_BAR; PG8_SCHED;
            PG8_LDB(B1, 1, 1); PG8_STAGE(PG8_SB(1, 0), b3, voffB);
            PG8_BAR; PG8_WAIT_L(0); PG8_MMA(0, 1, At, B1); PG8_BAR;
            PG8_LDA(At, 1, 1); PG8_STAGE(PG8_SA(1, 0), a3, voffA);
            PG8_BAR; PG8_WAIT_L(0); PG8_MMA(1, 0, At, B0); PG8_BAR; PG8_SCHED;
            PG8_STAGE(PG8_SB(1, 1), b3 + hstep, voffB);
            PG8_WAIT_V(6); PG8_BAR; PG8_MMA(1, 1, At, B1); PG8_BAR;
            }
        }
#ifdef PROBE_EPI_T
        unsigned te0_ = 0; if constexpr (Epi::TIMED) te0_ = (unsigned)__builtin_amdgcn_s_memrealtime();
#endif
        if constexpr (ALIGN_EPI) { if (wr == 0) PG8_BAR; }
        if constexpr (ALIGN_EPI && SP2) { if (has_next) { PG8_STAGE(PG8_SA(1, 1), nA + kstep + hstep, voffA); xs = E.nstores(cur); } }
        if constexpr (!Epi::AFTER_DRAIN) {
#ifdef PROBE_EPI2
            if constexpr (Epi::PERM) {
                _Pragma("unroll 1") for (int rep_ = 0; rep_ < E.nrep; ++rep_) { E(acc, cur, wr, wc, fr, fq, est); asm volatile("" ::: "memory"); }
            } else
#endif
            { if (has_next) E.pre_load(pre, nxt, wr, wc, fr, fq); else E.pre_none(pre);
              E(acc, cur, wr, wc, fr, fq, est); }
            S.done(cur); }
#ifdef PROBE_EPI_T
        if constexpr (Epi::TIMED) { if (tid == 0) { asm volatile("s_waitcnt vmcnt(0)" ::: "memory"); E.tacc[0] += (unsigned)__builtin_amdgcn_s_memrealtime() - te0_; } }
#endif
        if (!has_next) break;
        E.pre_apply(acc, pre);
        cur = nxt; cA = nA; cB = nB; ++ui;
        if constexpr (ALIGN_EPI) { if (wr == 1) PG8_BAR; }
    }
    PG8_WAIT_V(0);
    if constexpr (!ALIGN_EPI) { if (wr == 0) PG8_BAR; }
    PG8_BAR;
    if constexpr (Epi::AFTER_DRAIN) { E.fused(acc, cur, wr, wc, fr, fq, lds, wid, lane); S.done(cur); }
#undef PG8_SA
#undef PG8_SB
#undef PG8_STAGE
#undef PG8_LDA
#undef PG8_LDB
#undef PG8_MMA
#undef PG8_WAIT_V
#undef PG8_WAIT_VN
#undef PG8_WAIT_V8X
#undef PG8_WAIT_L
#undef PG8_BAR
#undef PG8_SCHED
}
}

#ifndef PG8_SP2
#define PG8_SP2 true
#endif
#ifndef PG8_ALIGN
#define PG8_ALIGN true
#endif
#include <hip/hip_bf16.h>
#include <cmath>
namespace attn_body {
using bf16=__hip_bfloat16;
using bf16x8=__attribute__((ext_vector_type(8)))short;
using s16x4=__attribute__((ext_vector_type(4)))short;
using f32x16=__attribute__((ext_vector_type(16)))float;
using u32x4=__attribute__((ext_vector_type(4)))unsigned;
constexpr int SEQ=4096,D=64,PQ=512,PO=1024;
constexpr int NW=8,QBLK=32,QB=QBLK*NW,KVBLK=64,NQB=SEQ/QB;
constexpr int ATTN_UNIT_ROWS=QB;
__device__ __forceinline__ int crow(int r,int hi){return (r&3)+8*(r>>2)+4*hi;}
#define SBAR() __builtin_amdgcn_sched_barrier(0)
__device__ __forceinline__ void cmask(f32x16&p0,f32x16&p1,int jb,int qrel,int hi){
  const float NEG=-INFINITY; const int x=qrel-4*hi-64*jb;
  #pragma unroll
  for(int r=0;r<16;++r){const int c=(r&3)+8*(r>>2); if(c>x)p0[r]=NEG; if(c+32>x)p1[r]=NEG;}
}

constexpr int NSLOT=3, SLOTB=8192;
constexpr int LDS_QB=110592;
constexpr int LDS_K=0, LDS_V=NSLOT*SLOTB;
constexpr float C2=0.125f*1.4426950408889634f;
__device__ __forceinline__ void glds16(const void*gsrc,unsigned lds_dst){unsigned keep;
  asm volatile("s_mov_b32 %0, m0\n\ts_mov_b32 m0, %2\n\ts_nop 0\n\tglobal_load_lds_dwordx4 %1, off\n\ts_mov_b32 m0, %0":"=&s"(keep):"v"(gsrc),"s"(lds_dst):"memory");}
__device__ __forceinline__ void glds16s(const void*sbase,unsigned voff,unsigned lds_dst){unsigned keep;
  const unsigned long long b=(unsigned long long)(uintptr_t)sbase; const unsigned blo=__builtin_amdgcn_readfirstlane((unsigned)b),bhi=__builtin_amdgcn_readfirstlane((unsigned)(b>>32));
  const unsigned long long bu=((unsigned long long)bhi<<32)|blo;
  asm volatile("s_mov_b32 %0, m0\n\ts_mov_b32 m0, %2\n\ts_nop 0\n\tglobal_load_lds_dwordx4 %1, %3\n\ts_mov_b32 m0, %0":"=&s"(keep):"v"(voff),"s"(lds_dst),"s"(bu):"memory");}
__device__ __forceinline__ float max3f(float a,float b,float c){float r;asm("v_max3_f32 %0, %1, %2, %3":"=v"(r):"v"(a),"v"(b),"v"(c));return r;}
__device__ __forceinline__ float max2f(float a,float b){float r;asm("v_max_f32_e32 %0, %1, %2":"=v"(r):"v"(a),"v"(b));return r;}
__device__ __forceinline__ float fadd_s(float a,float b){float r;asm("v_add_f32_e32 %0, %1, %2":"=v"(r):"v"(a),"v"(b));return r;}
__device__ __forceinline__ float fsub_s(float a,float b){float r;asm("v_sub_f32_e32 %0, %1, %2":"=v"(r):"v"(a),"v"(b));return r;}
typedef float f32x2_t __attribute__((ext_vector_type(2))); typedef float f32x4_t __attribute__((ext_vector_type(4))); typedef __bf16 bf16x2_t __attribute__((ext_vector_type(2)));
__device__ __forceinline__ unsigned cvtpk_s(float lo,float hi){f32x2_t v={lo,hi};bf16x2_t b=__builtin_convertvector(v,bf16x2_t);return __builtin_bit_cast(unsigned,b);}
#define WAIT_BAR(N) asm volatile("s_waitcnt vmcnt(" #N ") lgkmcnt(0)\n\ts_barrier":::"memory")

__device__ __forceinline__ void qkt(f32x16&p0,f32x16&p1,const char*Kslot,const bf16x8*qr,const f32x16&negm,int r32,int hi){
  const char*kb=Kslot+hi*1024+r32*16;
  #pragma unroll
  for(int d0=0;d0<4;++d0){
    const bf16x8 b0=*reinterpret_cast<const bf16x8*>(kb+d0*2048);
    const bf16x8 b1=*reinterpret_cast<const bf16x8*>(kb+d0*2048+512);
    if(d0==0){p0=__builtin_amdgcn_mfma_f32_32x32x16_bf16(b0,qr[0],negm,0,0,0);p1=__builtin_amdgcn_mfma_f32_32x32x16_bf16(b1,qr[0],negm,0,0,0);}
    else{p0=__builtin_amdgcn_mfma_f32_32x32x16_bf16(b0,qr[d0],p0,0,0,0);p1=__builtin_amdgcn_mfma_f32_32x32x16_bf16(b1,qr[d0],p1,0,0,0);}}
}
typedef __attribute__((address_space(3))) const char* lds_cptr;
typedef short v4i16_t __attribute__((ext_vector_type(4)));
__device__ __forceinline__ void kload8(bf16x8*kf,lds_cptr kp){
  kf[0]=*(const __attribute__((address_space(3))) bf16x8*)(kp);      kf[1]=*(const __attribute__((address_space(3))) bf16x8*)(kp+512);
  kf[2]=*(const __attribute__((address_space(3))) bf16x8*)(kp+2048); kf[3]=*(const __attribute__((address_space(3))) bf16x8*)(kp+2560);
  kf[4]=*(const __attribute__((address_space(3))) bf16x8*)(kp+4096); kf[5]=*(const __attribute__((address_space(3))) bf16x8*)(kp+4608);
  kf[6]=*(const __attribute__((address_space(3))) bf16x8*)(kp+6144); kf[7]=*(const __attribute__((address_space(3))) bf16x8*)(kp+6656);
}
__device__ __forceinline__ void kload2(bf16x8*kf,lds_cptr kp,int j){ kf[2*j]=*(const __attribute__((address_space(3))) bf16x8*)(kp+j*2048); kf[2*j+1]=*(const __attribute__((address_space(3))) bf16x8*)(kp+j*2048+512); }
__device__ __forceinline__ s16x4 vtr(lds_cptr p){ return __builtin_bit_cast(s16x4,__builtin_amdgcn_ds_read_tr16_b64_v4i16((__attribute__((address_space(3))) v4i16_t*)p)); }
__device__ __forceinline__ float rowmax(const f32x16&p0,const f32x16&p1){
  float a=max3f(p0[0],p0[1],p1[0]),b=max3f(p0[2],p0[3],p1[1]);a=max3f(a,p1[2],p1[3]);
  #pragma unroll
  for(int r=4;r<16;r+=4){a=max3f(a,p0[r],p0[r+1]);b=max3f(b,p0[r+2],p0[r+3]);a=max3f(a,p1[r],p1[r+1]);b=max3f(b,p1[r+2],p1[r+3]);}
  const float m=max2f(a,b);
  auto rr=__builtin_amdgcn_permlane32_swap(__float_as_uint(m),__float_as_uint(m),false,false);
  return max2f(__uint_as_float(rr[0]),__uint_as_float(rr[1]));
}
__device__ __forceinline__ void pv(f32x16*o,int vb,bf16x8 pa0,bf16x8 pa1,bf16x8 pa2,bf16x8 pa3){
  #pragma unroll
  for(int d0=0;d0<2;++d0){s16x4 lo[4],hi[4];
    #pragma unroll
    for(int ks=0;ks<4;++ks){
      asm volatile("ds_read_b64_tr_b16 %0,%1 offset:%c2":"=&v"(lo[ks]):"v"(vb),"i"(d0*4096+ks*1024):"memory");
      asm volatile("ds_read_b64_tr_b16 %0,%1 offset:%c2":"=&v"(hi[ks]):"v"(vb),"i"(d0*4096+ks*1024+512):"memory");}
    asm volatile("s_waitcnt lgkmcnt(0)":::"memory");SBAR();
    #define PK(k) (bf16x8){lo[k][0],lo[k][1],lo[k][2],lo[k][3],hi[k][0],hi[k][1],hi[k][2],hi[k][3]}
    o[d0]=__builtin_amdgcn_mfma_f32_32x32x16_bf16(pa0,PK(0),o[d0],0,0,0);
    o[d0]=__builtin_amdgcn_mfma_f32_32x32x16_bf16(pa1,PK(1),o[d0],0,0,0);
    o[d0]=__builtin_amdgcn_mfma_f32_32x32x16_bf16(pa2,PK(2),o[d0],0,0,0);
    o[d0]=__builtin_amdgcn_mfma_f32_32x32x16_bf16(pa3,PK(3),o[d0],0,0,0);
    #undef PK
  }
}

#ifndef ATTN_STORE16
#define ATTN_STORE16(p,v) (*(u32x4*)(p)=(v))
#endif
__device__ __forceinline__ void split3(float x,unsigned&w1,unsigned&w2,unsigned&w3){
  w1=cvtpk_s(x,0.f); const float r1=x-__uint_as_float(w1<<16); w2=cvtpk_s(r1,0.f); const float r2=r1-__uint_as_float(w2<<16); w3=cvtpk_s(r2,0.f); }
struct UnitDesc { const bf16*Q; const bf16*K; const bf16*V; bf16*O; const bf16*G; const float*KM; float a2; float sbc; int qb; int np; int mode; float*O1; const float*SW; float lam; unsigned*qnext; int qslot; const bf16*pfK; const bf16*pfQ; int pfq2; int pre; };
template<int THRL,int NVH> __device__ __forceinline__ void attn_unit(const UnitDesc&U,char*shm,const int tid){
  constexpr int LDS_WS=LDS_V+NSLOT*SLOTB*NVH, LDS_OST=LDS_WS+NW*64*4;
  const bf16*Q=U.Q; const bf16*__restrict__ K=U.K; const bf16*__restrict__ V=U.V; bf16*O=U.O; const int qb=U.qb; const float a2=U.a2;
  const int lane=tid&63,r32=lane&31,hi=lane>>5; const int wid=__builtin_amdgcn_readfirstlane(tid>>6);
  const int q0=qb*QB;
  const bf16*Qw=Q+(long)(q0+wid*QBLK)*PQ;
  const bf16*Kh=K,*Vh=V;
  const unsigned lds0=(unsigned)(uintptr_t)shm;
  float*wsf=(float*)(shm+LDS_WS)+wid*64;
  const unsigned koff=(unsigned)((lane*PQ+wid*8)*2);
  const unsigned voff=(unsigned)(((16*(wid&3)+(lane>>2))*PQ+(wid>>2)*32+(lane&3)*8)*2);
  const unsigned kdst=lds0+LDS_K+wid*1024, vdst=lds0+LDS_V+wid*1024;
  #define KT(t) (((t)<4)?(NTF-4+(t)):(NTF-1-(t)))
  #define DMA_K(t,slot) glds16s(Kh+(long)KT(t)*KVBLK*PQ,koff,(unsigned)__builtin_amdgcn_readfirstlane(kdst+(slot)))
  #define DMA_V(t,slot) do{ glds16s(Vh+(long)KT(t)*KVBLK*PQ,voff,(unsigned)__builtin_amdgcn_readfirstlane(vdst+(slot)*NVH)); \
    if constexpr(NVH==2){ glds16s(Vh+(long)KT(t)*KVBLK*PQ+64,voff,(unsigned)__builtin_amdgcn_readfirstlane(vdst+(slot)*NVH+8192)); } }while(0)
  const int vb0=(int)(lds0+LDS_V)+((lane>>4)&1)*32+(lane&3)*8+(4*hi+((lane&15)>>2))*64;
  const char*Kbase=shm+LDS_K; bf16x8 kf[8];
  const lds_cptr shm3=(lds_cptr)shm; const lds_cptr kp0=shm3+LDS_K+hi*1024+r32*16; const lds_cptr vp0=shm3+LDS_V+((lane>>4)&1)*32+(lane&3)*8+(4*hi+((lane&15)>>2))*64;
  const int NTF=(q0+QB)/KVBLK, NT=4+U.np;
#if defined(PROBE_ATT_T) && !defined(PROBE_P0_T)
  unsigned tprev_=(unsigned)__builtin_amdgcn_s_memrealtime();
#endif
  unsigned selmask=0xFFFFu;
#if defined(PROBE_ATT_T) && !defined(PROBE_P0_T)
  { const unsigned tn_=(unsigned)__builtin_amdgcn_s_memrealtime(); if(tid==0){ volatile unsigned*ta_=(volatile unsigned*)(shm+147776+160); ta_[1]+=tn_-tprev_; } tprev_=tn_; }
#endif
  constexpr int LDS_OST2=LDS_V+NSLOT*SLOTB*2+NW*64*4;
  const bool pre=(U.pre!=0);
  if(!pre){DMA_K(0,0);} DMA_V(0,0); if(!pre){DMA_K(1,SLOTB);}
  bf16x8 qr[4];
  const lds_cptr qlp=(lds_cptr)shm+((NVH==2&&U.mode==2)?LDS_OST2:LDS_QB)+wid*4096+lane*16;
  if(!pre){
    #pragma unroll
    for(int d0=0;d0<4;++d0)qr[d0]=*reinterpret_cast<const bf16x8*>(&Qw[(long)r32*PQ+d0*16+hi*8]);
    if constexpr(NVH==2){
      #pragma unroll
      for(int d0=0;d0<4;++d0)*(__attribute__((address_space(3))) bf16x8*)((__attribute__((address_space(3))) char*)qlp+d0*1024)=qr[d0];
    }
  }
  #define QPRE() do{ if(pre){ if constexpr(NVH==1){asm volatile("s_waitcnt vmcnt(1)":::"memory");} else {asm volatile("s_waitcnt vmcnt(2)":::"memory");} \
    _Pragma("unroll") for(int d0=0;d0<4;++d0)qr[d0]=*(const __attribute__((address_space(3))) bf16x8*)(qlp+d0*1024); } }while(0)
  float mhat=0.f,l_reg=0.f;f32x16 o[2*NVH];
  #pragma unroll
  for(int d_=0;d_<2*NVH;++d_)o[d_]=f32x16{};
  const f32x16 negm=f32x16{};
  const int qrel=wid*QBLK+r32;
  #define CMASK(P0,P1,t) do{ if((t)<4)cmask(P0,P1,(t),qrel,hi); }while(0)
  const int qend=q0+QB-1;
  bf16x8 kfa0,kfa1; u32x4 qa={0x3F803F80u,0x3F80u,0u,0u};
  { unsigned a1,a2b,a3,b1,b2,b3; split3(a2*(float)r32,a1,a2b,a3); split3(a2*(float)(r32+32),b1,b2,b3);
    u32x4 k0={a1|(a2b<<16),a3|0x3F800000u,0x3F803F80u,0x3F80u},k1={b1|(b2<<16),b3|0x3F800000u,0x3F803F80u,0x3F80u};
    if(hi){k0=u32x4{0u,0u,0u,0u};k1=k0;}
    kfa0=__builtin_bit_cast(bf16x8,k0);kfa1=__builtin_bit_cast(bf16x8,k1); }
  #define QAUG(t) do{ const int kt_=KT(t); const float u_=a2*(float)(64*kt_-qend)-mhat; unsigned w1_,w2_,w3_; split3(u_,w1_,w2_,w3_); \
    qa.y=0x3F80u|(w1_<<16); qa.z=w2_|(w3_<<16); qa.w=((t)>=4 && (((selmask>>(kt_>>2))&1u)==0u))?0xF14Au:0u; }while(0)
  #define QAF __builtin_bit_cast(bf16x8,qa)
  bool resc=false;
  #define START(P0,P1) do{ const float rm=rowmax(P0,P1); resc=false; \
    { const float dl=rm; mhat=fadd_s(mhat,dl); \
      _Pragma("unroll") for(int r=0;r<16;++r){P0[r]=fsub_s(P0[r],dl);P1[r]=fsub_s(P1[r],dl);} \
      } \
    _Pragma("unroll") for(int r=0;r<16;++r)P0[r]=__builtin_amdgcn_exp2f(P0[r]); }while(0)
  #define RESC() do{ if(resc){ asm volatile("s_waitcnt lgkmcnt(0)":::"memory"); \
      _Pragma("unroll") for(int d_=0;d_<2*NVH;++d_) _Pragma("unroll") for(int r=0;r<16;++r)o[d_][r]*=wsf[crow(r,hi)]; } }while(0)
  f32x16 pA0,pA1,pB0,pB1;
  int sl_prev=0,sl_cur=0,sl_next=SLOTB;
  #define ROT() do{sl_prev=sl_cur;sl_cur=sl_next;sl_next=(sl_next==(NSLOT-1)*SLOTB)?0:sl_next+SLOTB;}while(0)
  if(!pre){DMA_K(2,2*SLOTB);}
  if(U.KM!=nullptr && qb>3){
    char*img=shm+LDS_OST;
    int lane_g=lane; asm volatile("":"+v"(lane_g));
    for(int i=wid*64+lane_g;i<1024;i+=NW*64){ const int j=i>>6,d=i&63; const float s=(j<qb)?(U.KM[(j*2)*64+d]+U.KM[(j*2+1)*64+d]):0.f;
      const unsigned hp=cvtpk_s(s,0.f); const unsigned lp=cvtpk_s(s-__uint_as_float(hp<<16),0.f); const int off=(d>>3)*512+j*16+(d&7)*2;
      *reinterpret_cast<unsigned short*>(img+off)=(unsigned short)hp; *reinterpret_cast<unsigned short*>(img+4096+off)=(unsigned short)lp; }
    __syncthreads();
    QPRE();
    const int r32g=lane_g&31,hig=lane_g>>5;
    f32x16 gacc=f32x16{};
    #pragma unroll
    for(int d0=0;d0<4;++d0){ const bf16x8 ah=*reinterpret_cast<const bf16x8*>(img+(2*d0+hig)*512+r32g*16), al=*reinterpret_cast<const bf16x8*>(img+4096+(2*d0+hig)*512+r32g*16);
      gacc=__builtin_amdgcn_mfma_f32_32x32x16_bf16(ah,qr[d0],gacc,0,0,0); gacc=__builtin_amdgcn_mfma_f32_32x32x16_bf16(al,qr[d0],gacc,0,0,0); }
    const float KLOW=-3.0e38f;
    float ta=-3.2e38f,tb=-3.2e38f,tc=-3.2e38f;
    #define TOP3_INS(x) do{ const float x_=(x); const float u_=__builtin_fminf(__builtin_fminf(ta,tb),x_); const float b_=__builtin_amdgcn_fmed3f(ta,tb,x_); ta=__builtin_fmaxf(ta,x_); tb=b_; tc=__builtin_fmaxf(tc,u_); }while(0)
    #define TOP3_KEY(g,j) __uint_as_float((__float_as_uint(g)&0xFFFFFFF0u)|(unsigned)(15-(j)))
    #pragma unroll
    for(int r=0;r<8;++r){ const int bl=(r&3)+8*(r>>2); float g=gacc[r]; if(bl+4*hig>=qb)g=KLOW;
      auto rr=__builtin_amdgcn_permlane32_swap(__float_as_uint(g),__float_as_uint(g),false,false);
      TOP3_INS(TOP3_KEY(__uint_as_float(rr[0]),bl)); TOP3_INS(TOP3_KEY(__uint_as_float(rr[1]),bl+4)); }
    unsigned m=0u;
    if(ta>-1.0e38f)m|=1u<<(15u-(__float_as_uint(ta)&15u));
    if(tb>-1.0e38f)m|=1u<<(15u-(__float_as_uint(tb)&15u));
    if(tc>-1.0e38f)m|=1u<<(15u-(__float_as_uint(tc)&15u));
    #undef TOP3_INS
    #undef TOP3_KEY
    selmask=m;
  } else { QPRE(); }
  #undef QPRE
  #define WAIT_BAR_N(n) do{ if constexpr((n)==0){WAIT_BAR(0);} else if constexpr((n)==1){WAIT_BAR(1);} else if constexpr((n)==2){WAIT_BAR(2);} else if constexpr((n)==3){WAIT_BAR(3);} else {static_assert((n)<=4,"");WAIT_BAR(4);} }while(0)
  if(pre){WAIT_BAR_N(NVH);} else {WAIT_BAR_N(2+NVH);}

#if defined(PROBE_ATT_T) && !defined(PROBE_P0_T)
  { const unsigned tn_=(unsigned)__builtin_amdgcn_s_memrealtime(); if(tid==0){ volatile unsigned*ta_=(volatile unsigned*)(shm+147776+160); ta_[5]+=tn_-tprev_; } tprev_=tn_; }
#endif
  QAUG(0); qkt(pA0,pA1,Kbase,qr,negm,r32,hi);pA0=__builtin_amdgcn_mfma_f32_32x32x16_bf16(kfa0,QAF,pA0,0,0,0);pA1=__builtin_amdgcn_mfma_f32_32x32x16_bf16(kfa1,QAF,pA1,0,0,0);asm volatile("s_nop 15\n\ts_nop 7":"+v"(pA0),"+v"(pA1));CMASK(pA0,pA1,0);
  START(pA0,pA1);
  QAUG(1);
  _Pragma("unroll") for(int r=0;r<16;++r)pA1[r]=__builtin_amdgcn_exp2f(pA1[r]);

#if defined(PROBE_ATT_T) && !defined(PROBE_P0_T)
  { const unsigned tn_=(unsigned)__builtin_amdgcn_s_memrealtime(); if(tid==0){ volatile unsigned*ta_=(volatile unsigned*)(shm+147776+160); ta_[6]+=tn_-tprev_; } tprev_=tn_; }
#endif
  WAIT_BAR(0);

#if defined(PROBE_ATT_T) && !defined(PROBE_P0_T)
  { const unsigned tn_=(unsigned)__builtin_amdgcn_s_memrealtime(); if(tid==0){ volatile unsigned*ta_=(volatile unsigned*)(shm+147776+160); ta_[7]+=tn_-tprev_; } tprev_=tn_; }
#endif
  DMA_K(3,0);DMA_V(1,SLOTB);
  ROT();
  kload8(kf,kp0+sl_cur);
  WAIT_BAR_N(1+NVH);
  s16x4 vlo[8],vhi[8]; u32x4 pw0,pw1,pw2,pw3;
  #define PKW(P,B) cvtpk_s(P[B],P[B+1])
  #define PAF(k) __builtin_bit_cast(bf16x8,pw##k)
  #define VFR(i) (bf16x8){vlo[i][0],vlo[i][1],vlo[i][2],vlo[i][3],vhi[i][0],vhi[i][1],vhi[i][2],vhi[i][3]}
  #define PIN(x) asm volatile("":"+v"(x))
  #define MX3(a,b,c) __builtin_fmaxf(__builtin_fmaxf((a),(b)),(c))
  #define GAPA(MF,A0,A1,A2,A3,W0,W1,PW) do{ MF; sacc+=A0; sacc+=A1; sacc+=A2; sacc+=A3; PIN(sacc); W0; W1; PIN(PW); SBAR(); }while(0)
  #define EX(v) __builtin_amdgcn_exp2f(v)
  #define GAPB(MF,X,B) do{ MF; X[B]=EX(X[B]); X[B+1]=EX(X[B+1]); X[B+2]=EX(X[B+2]); X[B+3]=EX(X[B+3]); PIN(X); SBAR(); }while(0)
  #define GAPB2(MF,X,B,RL) do{ MF; X[B]=EX(X[B]); X[B+1]=EX(X[B+1]); RL; PIN(X); SBAR(); }while(0)
  #define VRDB(i) do{ vlo[i]=vtr(vp_+(8192+((i)>>2)*4096+((i)&3)*1024)); vhi[i]=vtr(vp_+(8192+((i)>>2)*4096+((i)&3)*1024+512)); }while(0)
  #define VRD(i) do{ vlo[i]=vtr(vp_+(((i)>>2)*4096+((i)&3)*1024)); vhi[i]=vtr(vp_+(((i)>>2)*4096+((i)&3)*1024+512)); }while(0)
  #define KRD(G,j) do{ if(G){ kload2(kf,kp0+sl_next,j); SBAR(); } }while(0)
  bf16x8 qx_=qr[0],qy_=qr[1];
  #define QX  (NVH==2?qx_:qr[0])
  #define QY  (NVH==2?qy_:qr[1])
  #define QX2 (NVH==2?qx_:qr[2])
  #define QY3 (NVH==2?qy_:qr[3])
  #define QLD(dst,d0) do{ if constexpr(NVH==2){ dst=*(const __attribute__((address_space(3))) bf16x8*)(qlp+(d0)*1024); } }while(0)
  #define STEP(C0,C1,P0,P1,t,GK,GV,GL) do{ SBAR(); \
    const lds_cptr vp_=vp0+sl_prev*NVH; \
    VRD(0); SBAR(); float sacc=(P0[0]+P0[1]); \
    GAPA(C0=__builtin_amdgcn_mfma_f32_32x32x16_bf16(kf[0],QX,negm,0,0,0), P0[2],P0[3],P0[4],P0[5],     pw0[0]=PKW(P0,0), pw0[1]=PKW(P0,2), pw0); QLD(qy_,1); \
    VRD(4); SBAR(); GAPA(C1=__builtin_amdgcn_mfma_f32_32x32x16_bf16(kf[1],QX,negm,0,0,0), P0[6],P0[7],P0[8],P0[9],     pw0[2]=PKW(P0,4), pw0[3]=PKW(P0,6), pw0); \
    VRD(1); SBAR(); GAPA(C0=__builtin_amdgcn_mfma_f32_32x32x16_bf16(kf[2],QY,C0,0,0,0),   P0[10],P0[11],P0[12],P0[13], pw1[0]=PKW(P0,8), pw1[1]=PKW(P0,10), pw1); QLD(qx_,2); \
    VRD(5); SBAR(); GAPA(C1=__builtin_amdgcn_mfma_f32_32x32x16_bf16(kf[3],QY,C1,0,0,0),   P0[14],P0[15],P1[0],P1[1],   pw1[2]=PKW(P0,12),pw1[3]=PKW(P0,14), pw1); \
    VRD(2); SBAR(); GAPA(C0=__builtin_amdgcn_mfma_f32_32x32x16_bf16(kf[4],QX2,C0,0,0,0),   P1[2],P1[3],P1[4],P1[5],     pw2[0]=PKW(P1,0), pw2[1]=PKW(P1,2), pw2); QLD(qy_,3); \
    VRD(6); SBAR(); GAPA(C1=__builtin_amdgcn_mfma_f32_32x32x16_bf16(kf[5],QX2,C1,0,0,0),   P1[6],P1[7],P1[8],P1[9],     pw2[2]=PKW(P1,4), pw2[3]=PKW(P1,6), pw2); \
    VRD(3); SBAR(); GAPA(C0=__builtin_amdgcn_mfma_f32_32x32x16_bf16(kf[6],QY3,C0,0,0,0),   P1[10],P1[11],P1[12],P1[13], pw3[0]=PKW(P1,8), pw3[1]=PKW(P1,10), pw3); QLD(qx_,0); \
    VRD(7); SBAR(); GAPA(C1=__builtin_amdgcn_mfma_f32_32x32x16_bf16(kf[7],QY3,C1,0,0,0),   P1[14],P1[15],0.f,0.f,       pw3[2]=PKW(P1,12),pw3[3]=PKW(P1,14), pw3); \
    C0=__builtin_amdgcn_mfma_f32_32x32x16_bf16(kfa0,QAF,C0,0,0,0); C1=__builtin_amdgcn_mfma_f32_32x32x16_bf16(kfa1,QAF,C1,0,0,0); \
    l_reg+=sacc; \
    if(GK){DMA_K((t)+3,sl_cur);} if(GV){DMA_V((t)+1,sl_next);} \
    CMASK(C0,C1,t); \
    resc=false; \
      \
      \
    if(__builtin_expect(__any(a2*(float)(64*KT(t)-qend)-mhat+U.sbc>(float)THRL-0.0625f),0)) \
    { float a=MX3(C0[0],C0[1],C1[0]),b=MX3(C0[2],C0[3],C1[1]); a=MX3(a,C1[2],C1[3]); \
      _Pragma("unroll") for(int r=4;r<16;r+=4){a=MX3(a,C0[r],C0[r+1]);b=MX3(b,C0[r+2],C0[r+3]);a=MX3(a,C1[r],C1[r+1]);b=MX3(b,C1[r+2],C1[r+3]);} \
      float rm=__builtin_fmaxf(a,b); { auto rr=__builtin_amdgcn_permlane32_swap(__float_as_uint(rm),__float_as_uint(rm),false,false); rm=__builtin_fmaxf(__uint_as_float(rr[0]),__uint_as_float(rr[1])); } \
      if(__builtin_expect(__any(rm>(float)THRL),0)){ const float dl=__builtin_fmaxf(rm,0.f); mhat+=dl; \
        _Pragma("unroll") for(int r=0;r<16;++r){C0[r]-=dl;C1[r]-=dl;} \
        const float f=__builtin_amdgcn_exp2f(-dl); l_reg*=f; if(hi==0)wsf[r32]=f; resc=true; } } \
    QAUG((t)+1);   \
    SBAR(); \
    if constexpr(NVH==1){ \
      GAPB(o[0]=__builtin_amdgcn_mfma_f32_32x32x16_bf16(PAF(0),VFR(0),o[0],0,0,0), C0,0); \
      GAPB(o[1]=__builtin_amdgcn_mfma_f32_32x32x16_bf16(PAF(0),VFR(4),o[1],0,0,0), C0,4); \
      KRD(GL,0); GAPB(o[0]=__builtin_amdgcn_mfma_f32_32x32x16_bf16(PAF(1),VFR(1),o[0],0,0,0), C0,8); \
      KRD(GL,1); GAPB(o[1]=__builtin_amdgcn_mfma_f32_32x32x16_bf16(PAF(1),VFR(5),o[1],0,0,0), C0,12); \
      KRD(GL,2); GAPB(o[0]=__builtin_amdgcn_mfma_f32_32x32x16_bf16(PAF(2),VFR(2),o[0],0,0,0), C1,0); \
      KRD(GL,3); GAPB(o[1]=__builtin_amdgcn_mfma_f32_32x32x16_bf16(PAF(2),VFR(6),o[1],0,0,0), C1,4); \
      GAPB(o[0]=__builtin_amdgcn_mfma_f32_32x32x16_bf16(PAF(3),VFR(3),o[0],0,0,0), C1,8); \
      GAPB(o[1]=__builtin_amdgcn_mfma_f32_32x32x16_bf16(PAF(3),VFR(7),o[1],0,0,0), C1,12); \
    } else { \
      GAPB2(o[0]=__builtin_amdgcn_mfma_f32_32x32x16_bf16(PAF(0),VFR(0),o[0],0,0,0), C0,0, VRDB(0)); \
      GAPB2(o[1]=__builtin_amdgcn_mfma_f32_32x32x16_bf16(PAF(0),VFR(4),o[1],0,0,0), C0,2, VRDB(4)); \
      KRD(GL,0); GAPB2(o[0]=__builtin_amdgcn_mfma_f32_32x32x16_bf16(PAF(1),VFR(1),o[0],0,0,0), C0,4, VRDB(1)); \
      KRD(GL,1); GAPB2(o[1]=__builtin_amdgcn_mfma_f32_32x32x16_bf16(PAF(1),VFR(5),o[1],0,0,0), C0,6, VRDB(5)); \
      KRD(GL,2); GAPB2(o[0]=__builtin_amdgcn_mfma_f32_32x32x16_bf16(PAF(2),VFR(2),o[0],0,0,0), C0,8, VRDB(2)); \
      KRD(GL,3); GAPB2(o[1]=__builtin_amdgcn_mfma_f32_32x32x16_bf16(PAF(2),VFR(6),o[1],0,0,0), C0,10, VRDB(6)); \
      GAPB2(o[0]=__builtin_amdgcn_mfma_f32_32x32x16_bf16(PAF(3),VFR(3),o[0],0,0,0), C0,12, VRDB(3)); \
      GAPB2(o[1]=__builtin_amdgcn_mfma_f32_32x32x16_bf16(PAF(3),VFR(7),o[1],0,0,0), C0,14, VRDB(7)); \
      GAPB2(o[2]=__builtin_amdgcn_mfma_f32_32x32x16_bf16(PAF(0),VFR(0),o[2],0,0,0), C1,0, (void)0); \
      GAPB2(o[3]=__builtin_amdgcn_mfma_f32_32x32x16_bf16(PAF(0),VFR(4),o[3],0,0,0), C1,2, (void)0); \
      GAPB2(o[2]=__builtin_amdgcn_mfma_f32_32x32x16_bf16(PAF(1),VFR(1),o[2],0,0,0), C1,4, (void)0); \
      GAPB2(o[3]=__builtin_amdgcn_mfma_f32_32x32x16_bf16(PAF(1),VFR(5),o[3],0,0,0), C1,6, (void)0); \
      GAPB2(o[2]=__builtin_amdgcn_mfma_f32_32x32x16_bf16(PAF(2),VFR(2),o[2],0,0,0), C1,8, (void)0); \
      GAPB2(o[3]=__builtin_amdgcn_mfma_f32_32x32x16_bf16(PAF(2),VFR(6),o[3],0,0,0), C1,10, (void)0); \
      GAPB2(o[2]=__builtin_amdgcn_mfma_f32_32x32x16_bf16(PAF(3),VFR(3),o[2],0,0,0), C1,12, (void)0); \
      GAPB2(o[3]=__builtin_amdgcn_mfma_f32_32x32x16_bf16(PAF(3),VFR(7),o[3],0,0,0), C1,14, (void)0); \
    } \
    }while(0)
  #define ENDW(tt) do{ if((tt)+3<NT){WAIT_BAR_N(1+NVH);} else if((tt)+2<NT){WAIT_BAR_N(NVH);} else {WAIT_BAR(0);} }while(0)

#if defined(PROBE_ATT_T) && !defined(PROBE_P0_T)
  { const unsigned tn_=(unsigned)__builtin_amdgcn_s_memrealtime(); if(tid==0){ volatile unsigned*ta_=(volatile unsigned*)(shm+147776+160); ta_[2]+=tn_-tprev_; } tprev_=tn_; }
#endif
  if(wid>=4)__builtin_amdgcn_s_setprio(1);
  int t=1;
  for(;t+1<NT;t+=2){
    STEP(pB0,pB1,pA0,pA1,t,(t+3<NT),(t+1<NT),(t+1<NT));       ENDW(t);   RESC(); ROT();
    STEP(pA0,pA1,pB0,pB1,t+1,(t+4<NT),(t+2<NT),(t+2<NT));     ENDW(t+1); RESC(); ROT();
  }
  if(U.pfK!=nullptr){
    glds16s(U.pfK,koff,(unsigned)__builtin_amdgcn_readfirstlane(kdst)); glds16s(U.pfK+(long)KVBLK*PQ,koff,(unsigned)__builtin_amdgcn_readfirstlane(kdst+SLOTB)); glds16s(U.pfK+(long)2*KVBLK*PQ,koff,(unsigned)__builtin_amdgcn_readfirstlane(kdst+2*SLOTB));
    int lane_p=lane; asm volatile("":"+v"(lane_p));
    const unsigned qoff=(unsigned)((((lane_p&31))*PQ+(lane_p>>5)*8)*2);
    const unsigned qdst=lds0+(U.pfq2?LDS_OST2:LDS_QB)+wid*4096;
    const bf16*qsrc=U.pfQ+(long)(wid*QBLK)*PQ;
    #pragma unroll
    for(int d0=0;d0<4;++d0)glds16s(qsrc+d0*16,qoff,(unsigned)__builtin_amdgcn_readfirstlane(qdst+d0*1024));
  }
  if(U.G!=nullptr && U.mode!=1){
    int lane_q=lane; asm volatile("":"+v"(lane_q));
    const unsigned goff=(unsigned)(((lane_q>>3)*PQ+(lane_q&7)*8)*2);
    const bf16*gsrc=U.G+(long)(q0+wid*QBLK)*PQ;
    const unsigned gdst=lds0+LDS_QB+wid*4096;
    #pragma unroll
    for(int i=0;i<4;++i)glds16s(gsrc+(long)(i*8)*PQ,goff,(unsigned)__builtin_amdgcn_readfirstlane(gdst+i*1024));
    if constexpr(NVH==2){
      #pragma unroll
      for(int i=0;i<2;++i)glds16s(gsrc+64+(long)(i*8)*PQ,goff,(unsigned)__builtin_amdgcn_readfirstlane(lds0+LDS_K+wid*2048+i*1024));
      #pragma unroll
      for(int i=2;i<4;++i)glds16s(gsrc+64+(long)(i*8)*PQ,goff,(unsigned)__builtin_amdgcn_readfirstlane(lds0+LDS_V+sl_next*NVH+wid*2048+(i-2)*1024));
    }
  }
  const int sl_free=sl_next;
  STEP(pB0,pB1,pA0,pA1,NT-1,false,false,false); RESC();
  __builtin_amdgcn_s_setprio(0);
  unsigned tk_=0u;
  if(U.qnext!=nullptr && tid==0){ long zo_=0; asm volatile("":"+v"(zo_)); tk_=__hip_atomic_fetch_add(U.qnext+zo_,1u,__ATOMIC_RELAXED,__HIP_MEMORY_SCOPE_AGENT); }
  { float sacc=pB0[0]+pB0[1]; _Pragma("unroll") for(int r=2;r<16;++r)sacc+=pB0[r]; _Pragma("unroll") for(int r=0;r<16;++r)sacc+=pB1[r]; l_reg+=sacc;
    pw0=(u32x4){PKW(pB0,0),PKW(pB0,2),PKW(pB0,4),PKW(pB0,6)};pw1=(u32x4){PKW(pB0,8),PKW(pB0,10),PKW(pB0,12),PKW(pB0,14)};pw2=(u32x4){PKW(pB1,0),PKW(pB1,2),PKW(pB1,4),PKW(pB1,6)};pw3=(u32x4){PKW(pB1,8),PKW(pB1,10),PKW(pB1,12),PKW(pB1,14)};
    SBAR(); pv(o,vb0+sl_cur*NVH,PAF(0),PAF(1),PAF(2),PAF(3)); if constexpr(NVH==2){ pv(o+2,vb0+sl_cur*NVH+8192,PAF(0),PAF(1),PAF(2),PAF(3)); } }
  #undef PKW
  #undef PAF
  #undef VFR
  #undef PIN
  #undef MX3
  #undef GAPA
  #undef GAPB
  #undef GAPB2
  #undef VRDB
  #undef EX
  #undef VRD
  #undef KRD
  #undef STEP
  #undef QX
  #undef QY
  #undef QX2
  #undef QY3
  #undef QLD
  #undef ENDW

#if defined(PROBE_ATT_T) && !defined(PROBE_P0_T)
  { const unsigned tn_=(unsigned)__builtin_amdgcn_s_memrealtime(); if(tid==0){ volatile unsigned*ta_=(volatile unsigned*)(shm+147776+160); ta_[3]+=tn_-tprev_; } tprev_=tn_; }
#endif
  int lane_e=lane; asm volatile("":"+v"(lane_e));
  const int hi_e=lane_e>>5,r32_e=lane_e&31;
  bf16*Ow=O+(long)(q0+wid*QBLK)*PO; const bf16*Gw=(U.G!=nullptr && U.mode!=1)?U.G+(long)(q0+wid*QBLK)*PQ:nullptr;
  const lds_cptr glp=shm3+LDS_QB+wid*4096+lane_e*16;
  f32x4_t swv[NVH==2?2:1][2];
  if constexpr(NVH==2){ if(U.mode==2){
    #pragma unroll
    for(int p=0;p<2;++p){ swv[p][0]=*reinterpret_cast<const f32x4_t*>(U.SW+p*64+(lane_e&7)*8); swv[p][1]=*reinterpret_cast<const f32x4_t*>(U.SW+p*64+(lane_e&7)*8+4); } } }
  f32x4_t o1v[NVH==2?2:1][4];
  float*o1=nullptr;
  if constexpr(NVH==2){ o1=U.O1+(long)wid*4096+lane_e*4;
    if(U.mode==2){
      #pragma unroll
      for(int d0=0;d0<2;++d0)
        #pragma unroll
        for(int r4=0;r4<4;++r4)o1v[d0][r4]=*reinterpret_cast<const f32x4_t*>(o1+(d0*4+r4)*256);
    } }
  {auto rr=__builtin_amdgcn_permlane32_swap(__float_as_uint(l_reg),__float_as_uint(l_reg),false,false);l_reg=__uint_as_float(rr[0])+__uint_as_float(rr[1]);}
  if(hi==0)wsf[32+r32]=l_reg;asm volatile("s_waitcnt lgkmcnt(0)":::"memory");
  float rli[16];
  #pragma unroll
  for(int r=0;r<16;++r)rli[r]=__builtin_amdgcn_rcpf(wsf[32+crow(r,0)+4*hi_e]);
  float rs[16];
  #pragma unroll
  for(int r=0;r<16;++r)rs[r]=rli[r];
  bool store_rows=true;
  if constexpr(NVH==2){
    if(U.mode==1){
      #pragma unroll
      for(int d0=0;d0<4;++d0)
        #pragma unroll
        for(int r4=0;r4<4;++r4){ f32x4_t v={o[d0][4*r4]*rli[4*r4],o[d0][4*r4+1]*rli[4*r4+1],o[d0][4*r4+2]*rli[4*r4+2],o[d0][4*r4+3]*rli[4*r4+3]}; *reinterpret_cast<f32x4_t*>(o1+(d0*4+r4)*256)=v; }
      store_rows=false;
    } else if(U.mode==2){
      float ss[16];
      #pragma unroll
      for(int r=0;r<16;++r)ss[r]=0.f;
      #pragma unroll
      for(int d0=0;d0<4;++d0)
        #pragma unroll
        for(int r4=0;r4<4;++r4){ f32x4_t v; if(d0<2)v=o1v[d0][r4]; else v=*reinterpret_cast<const f32x4_t*>(o1+(d0*4+r4)*256);
          #pragma unroll
          for(int j=0;j<4;++j){ const int r=4*r4+j; const float d=v[j]-U.lam*(o[d0][r]*rli[r]); o[d0][r]=d; ss[r]=__builtin_fmaf(d,d,ss[r]); } }
      #pragma unroll
      for(int r=0;r<16;++r){ float s=ss[r]; s+=__shfl_xor(s,1); s+=__shfl_xor(s,2); s+=__shfl_xor(s,4); s+=__shfl_xor(s,8); s+=__shfl_xor(s,16); rs[r]=__builtin_amdgcn_rsqf(s*(1.0f/128.0f)+1e-6f); }
    }
  }
  if(Gw){ if(wid==0 && U.qnext!=nullptr){asm volatile("s_waitcnt vmcnt(1)":::"memory");} else {asm volatile("s_waitcnt vmcnt(0)":::"memory");} }
  if(store_rows){ bf16*stg=(bf16*)(shm+LDS_OST)+wid*2048;
    bf16*stw=stg+hi_e*256+r32_e;
    #pragma unroll
    for(int p=0;p<NVH;++p){
    #pragma unroll
    for(int r=0;r<16;++r){const int orow=crow(r,0);
      #pragma unroll
      for(int d0=0;d0<2;++d0)stw[orow*64+d0*32]=__float2bfloat16(o[2*p+d0][r]*rs[r]);}
    asm volatile("s_waitcnt lgkmcnt(0)":::"memory");
    #pragma unroll
    for(int i=0;i<4;++i){const int row=i*8+(lane_e>>3),ch=lane_e&7; u32x4 v=*(const u32x4*)(stg+row*64+ch*8);
      if(Gw){ u32x4 gg; if(NVH==1||p==0)gg=*(const __attribute__((address_space(3))) u32x4*)(glp+i*1024);
        else gg=*(const __attribute__((address_space(3))) u32x4*)(shm3+((i<2)?(LDS_K+wid*2048+i*1024):(LDS_V+sl_free*NVH+wid*2048+(i-2)*1024))+lane_e*16);
        if(NVH==2 && U.mode==2){ const f32x4_t w0=swv[NVH==2?p:0][0],w1=swv[NVH==2?p:0][1];
          #define MUL3(a,b,wl,wh) cvtpk_s(__uint_as_float((a)<<16)*__uint_as_float((b)<<16)*(wl),__uint_as_float((a)&0xffff0000u)*__uint_as_float((b)&0xffff0000u)*(wh))
          v.x=MUL3(v.x,gg.x,w0[0],w0[1]);v.y=MUL3(v.y,gg.y,w0[2],w0[3]);v.z=MUL3(v.z,gg.z,w1[0],w1[1]);v.w=MUL3(v.w,gg.w,w1[2],w1[3]);
          #undef MUL3
        } else {
        #define MULPK(a,b) cvtpk_s(__uint_as_float((a)<<16)*__uint_as_float((b)<<16),__uint_as_float((a)&0xffff0000u)*__uint_as_float((b)&0xffff0000u))
        v.x=MULPK(v.x,gg.x);v.y=MULPK(v.y,gg.y);v.z=MULPK(v.z,gg.z);v.w=MULPK(v.w,gg.w);
        #undef MULPK
        }
      }
      ATTN_STORE16(Ow+(long)row*PO+p*64+ch*8,v);}
    asm volatile("s_waitcnt lgkmcnt(0)":::"memory");
    } }
  if(U.qnext!=nullptr && tid==0)*(__attribute__((address_space(3))) unsigned*)((__attribute__((address_space(3))) char*)shm3+U.qslot)=tk_;
  asm volatile("s_waitcnt lgkmcnt(0)\n\ts_barrier":::"memory");

#if defined(PROBE_ATT_T) && !defined(PROBE_P0_T)
  { const unsigned tn_=(unsigned)__builtin_amdgcn_s_memrealtime(); if(tid==0){ volatile unsigned*ta_=(volatile unsigned*)(shm+147776+160); ta_[4]+=tn_-tprev_; } tprev_=tn_; }
#endif
  #undef DMA_K
  #undef DMA_V
  #undef KT
  #undef QAUG
  #undef QAF
  #undef CMASK
  #undef START
  #undef RESC
  #undef ROT
}
constexpr int ATTN_LDS_BYTES=LDS_V+NSLOT*SLOTB*2+NW*64*4+NW*4096;
#undef SBAR
#undef WAIT_BAR
}
#define GAS __attribute__((address_space(1)))
#define LAS __attribute__((address_space(3)))
typedef unsigned short bf16;
typedef unsigned v4u __attribute__((ext_vector_type(4)));
typedef float f32x4 __attribute__((ext_vector_type(4)));
typedef short bf16x8 __attribute__((ext_vector_type(8)));
typedef GAS unsigned gu32;
typedef GAS unsigned long long gu64;
#define RLX_AGENT __ATOMIC_RELAXED, __HIP_MEMORY_SCOPE_AGENT
#define LDS_WAIT() asm volatile("s_waitcnt lgkmcnt(0)" ::: "memory")
#define VM_WAIT() asm volatile("s_waitcnt vmcnt(0)" ::: "memory")
__device__ __forceinline__ unsigned long long rt() { return __builtin_amdgcn_s_memrealtime(); }
__device__ __forceinline__ unsigned f2bf(float f) { unsigned u = __builtin_bit_cast(unsigned, f); return (u + 0x7fffu + ((u >> 16) & 1u)) >> 16; }
__device__ __forceinline__ unsigned pk2(float lo, float hi) { return f2bf(lo) | (f2bf(hi) << 16); }

#define XB_TMO      128
#define XB_XCNT(j)  (256  + 64 * (j))
#define XB_XSUB(j)  (1280 + 64 * (j))
#define XB_XGEN(j)  (2304 + 64 * (j))
#define XB_TOP      3328
#define XB_TOPGEN   3392
#define XCD_BAR_WORDS 3456
#define XB_SPIN_CAP (1u << 18)

__device__ __forceinline__ unsigned xb_ld(unsigned* p)              { return __hip_atomic_load(p, __ATOMIC_RELAXED, __HIP_MEMORY_SCOPE_AGENT); }
__device__ __forceinline__ unsigned xb_add(unsigned* p, unsigned v) { return __hip_atomic_fetch_add(p, v, __ATOMIC_RELAXED, __HIP_MEMORY_SCOPE_AGENT); }
__device__ __forceinline__ unsigned xb_xcc_id() { return (unsigned)__builtin_amdgcn_s_getreg((3 << 11) | 20) & 0xFu; }
#define XB_SPIN(cond, bar) do { unsigned _sp = 0; while (cond) { __builtin_amdgcn_s_sleep(1); \
    if ((++_sp & 255u) == 0u) { if (xb_ld(&(bar)[XB_TMO])) break; if (_sp > XB_SPIN_CAP) { atomicAdd(&(bar)[XB_TMO], 1u); break; } } } } while (0)

struct XcdBarrier {
    unsigned* bar; unsigned x;
    volatile LAS unsigned* st;
};

__device__ __forceinline__ XcdBarrier xcd_barrier_post(unsigned* bar, volatile LAS unsigned* st, const int tid) {
    XcdBarrier b; b.bar = bar; b.x = xb_xcc_id(); b.st = st;
    if (tid == 0) (void)xb_add(&bar[XB_XCNT(b.x)], 1u);
    return b;
}

__device__ __forceinline__ void xcd_barrier(const XcdBarrier& b, const int tid) {
    asm volatile("s_waitcnt vmcnt(0)" ::: "memory");
    __syncthreads();
    if (tid < 64 && b.st[0] == 0u) {
        unsigned* bar = b.bar;
        const unsigned G = gridDim.x * gridDim.y * gridDim.z;
        unsigned cnt = 1u, mine = 1u, sp = 0u;
        for (;;) {
            const unsigned c = (tid < 16) ? xb_ld(&bar[XB_XCNT(tid)]) : 0u;
            unsigned sum = c; sum += __shfl_xor(sum, 1); sum += __shfl_xor(sum, 2); sum += __shfl_xor(sum, 4); sum += __shfl_xor(sum, 8);
            sum = (unsigned)__builtin_amdgcn_readfirstlane((int)sum);
            cnt = (unsigned)__popcll(__ballot(c > 0u)); mine = (unsigned)__builtin_amdgcn_readlane((int)c, (int)b.x);
            if (sum == G) break;
            __builtin_amdgcn_s_sleep(1);
            if ((++sp & 255u) == 0u) { if (__builtin_amdgcn_readfirstlane((int)xb_ld(&bar[XB_TMO]))) break; if (sp > XB_SPIN_CAP) { if (tid == 0) atomicAdd(&bar[XB_TMO], 1u); break; } }
        }
        if (tid == 0) { b.st[0] = mine > 0u ? mine : 1u; b.st[1] = cnt > 0u ? cnt : 1u; }
    }
    if (tid == 0) {
        unsigned* bar = b.bar;
        __builtin_amdgcn_s_waitcnt(0);
        const unsigned nloc = b.st[0], nx = b.st[1];
        const unsigned old = xb_add(&bar[XB_XSUB(b.x)], 1u);
        const unsigned gen = old / nloc;
        if (old + 1u == (gen + 1u) * nloc) {
            __builtin_amdgcn_fence(__ATOMIC_RELEASE, "agent");
            asm volatile("s_waitcnt vmcnt(0)" ::: "memory");
            const unsigned og = xb_add(&bar[XB_TOP], 1u);
            const unsigned tg = og / nx;
            if (og + 1u == (tg + 1u) * nx) xb_add(&bar[XB_TOPGEN], 1u);
            else XB_SPIN(xb_ld(&bar[XB_TOPGEN]) == tg, bar);
            __builtin_amdgcn_fence(__ATOMIC_ACQUIRE, "agent");
            xb_add(&bar[XB_XGEN(b.x)], 1u);
            asm volatile("s_waitcnt vmcnt(0)" ::: "memory");
        } else {
            XB_SPIN(xb_ld(&bar[XB_XGEN(b.x)]) == gen, bar);
            __builtin_amdgcn_fence(__ATOMIC_ACQUIRE, "agent");
            asm volatile("s_waitcnt vmcnt(0)" ::: "memory");
        }
    }
    __syncthreads();
}
constexpr int NWAVES = 8;
#ifndef MK_PER_PHASE
#define MK_PER_PHASE 0
#endif
constexpr int BATCH = 8, SEQ = 4096, D = 1024, DEPTH = 2, INW = 4096;
constexpr int M = BATCH * SEQ;
constexpr float NORM_EPS = 1e-6f;
constexpr int N_PHASES = 1 + 3 * DEPTH;

constexpr size_t MiB = 1u << 20;
constexpr size_t WS_CTL = 0, CTL_ZERO_BYTES = 1 * MiB;
constexpr size_t WS_SSQ = 1 * MiB;
constexpr size_t WS_KMEAN = 3 * MiB;
constexpr size_t WS_NPAST = 3 * MiB + 512 * 1024;
constexpr size_t WS_PARM = 3 * MiB + 640 * 1024;
constexpr int PARM_SW = 0, PARM_LAMV = DEPTH * 128;
constexpr size_t WS_ORDER = 3 * MiB + 576 * 1024;
constexpr size_t WS_NORMW = 3 * MiB + 768 * 1024;
constexpr size_t WS_WIN = 4 * MiB;
constexpr size_t WS_WOUT = 20 * MiB;
constexpr size_t WS_XN = 32 * MiB;
constexpr size_t WS_PROJ = 96 * MiB;
constexpr size_t WS_MIX = 352 * MiB;
constexpr size_t WS_OD = 416 * MiB;
constexpr size_t WS_END = 480 * MiB;
constexpr int CW_TMO = 0, CW_CODE = 1;
constexpr int CW_BAR = 4096;
constexpr int CW_CVTQ = 30720;
constexpr int CW_ATTQ = 16384;

constexpr int RING_OFF = 0, RING_BYTES = 131072;
constexpr int LDSCTL_OFF = 147456, MISC_OFF = LDSCTL_OFF + 320;
constexpr int LDS_BYTES = 151552;
static_assert(MISC_OFF + 256 <= LDS_BYTES && attn_body::LDS_QB + 32768 <= LDSCTL_OFF && RING_BYTES <= LDSCTL_OFF && LDSCTL_OFF + 2048 + 192 <= LDS_BYTES, "LDS map");

struct Frame {
    LAS unsigned char* lds;
    volatile LAS unsigned* MISC;
    gu32* ctl;
    int wave;
    int vcu, G;
};
__device__ __forceinline__ int phase_tid(int wave) { int l; asm volatile("v_mbcnt_lo_u32_b32 %0, -1, 0\n\tv_mbcnt_hi_u32_b32 %0, -1, %0" : "=v"(l)); return (wave << 6) | l; }

__device__ __forceinline__ float wave_sum(float v) {
#pragma unroll
    for (int o = 1; o < 64; o <<= 1) v += __shfl_xor(v, o);
    return v;
}
template <bool PERMW>
__device__ __forceinline__ void p0_transpose_item(const float* W, int K, int N, bf16* WT, LAS float* scr, int item, int lane, const float* gk) {
    const int kblk = K / 16, nb = item / kblk, kb = item % kblk, k0 = 16 * kb, n0 = 128 * nb;
#pragma unroll
    for (int i = 0; i < 8; ++i) { const int kk = 2 * i + (lane >> 5); const float gg = gk ? gk[k0 + kk] : 1.0f;
        const f32x4 v = *(const GAS f32x4*)(W + (size_t)(k0 + kk) * N + n0 + 4 * (lane & 31)); *(LAS f32x4*)(scr + kk * 132 + 4 * (lane & 31)) = v * gg; }
    LDS_WAIT(); asm volatile("" ::: "memory");
#pragma unroll
    for (int h = 0; h < 2; ++h) { const int n = lane + 64 * h; const LAS float* s = scr + n;
        int r = n0 + n;
        if (PERMW) { const int pn = r >> 8, w = (r >> 6) & 3, bj = (r >> 5) & 1; r = (pn << 8) + (bj << 7) + (w << 5) + (r & 31); }
        v4u o0, o1;
        o0.x = pk2(s[0 * 132], s[1 * 132]); o0.y = pk2(s[2 * 132], s[3 * 132]); o0.z = pk2(s[4 * 132], s[5 * 132]); o0.w = pk2(s[6 * 132], s[7 * 132]);
        o1.x = pk2(s[8 * 132], s[9 * 132]); o1.y = pk2(s[10 * 132], s[11 * 132]); o1.z = pk2(s[12 * 132], s[13 * 132]); o1.w = pk2(s[14 * 132], s[15 * 132]);
        GAS v4u* dst = (GAS v4u*)(WT + (size_t)r * K + k0); dst[0] = o0; dst[1] = o1; }
    LDS_WAIT(); asm volatile("" ::: "memory");
}

struct Args { const float* in[13]; float* out; unsigned char* ws; int ph_lo, ph_hi; int nrep, pad; };

__device__ __forceinline__ void p0_prologue(Frame& FF, const Args& args) {
    struct { int lane, wave, vcu, G; LAS unsigned char* lds; } F;
    { const int t = phase_tid(FF.wave); F.lane = t & 63; F.wave = FF.wave; F.vcu = FF.vcu; F.G = FF.G; F.lds = FF.lds; }
    LAS float* scr = (LAS float*)(F.lds + RING_OFF + F.wave * 16384);
    const int gw = F.vcu * NWAVES + F.wave, NGW = F.G * NWAVES;
    if (gw == 0 || gw == NWAVES) {
        float w[DEPTH][4];
#pragma unroll
        for (int l = 0; l < DEPTH; ++l) { w[l][0] = args.in[3][l * 64 + F.lane]; w[l][1] = args.in[4][l * 64 + F.lane]; w[l][2] = args.in[5][l * 64 + F.lane]; w[l][3] = args.in[6][l * 64 + F.lane]; }
        if (gw == 0) {
            float* nw = (float*)(args.ws + WS_NORMW);
#pragma unroll
            for (int l = 0; l < DEPTH; ++l)
#pragma unroll
                for (int k = 0; k < 4; ++k) nw[(l * 4 + k) * 64 + F.lane] = w[l][k];
        } else {
            int* npast = (int*)(args.ws + WS_NPAST);
#pragma unroll
            for (int l = 0; l < DEPTH; ++l) {
                float mq = fabsf(w[l][0]), mk = fabsf(w[l][1]), dq = fabsf(w[l][2]), dk = fabsf(w[l][3]);
#pragma unroll
                for (int o = 1; o < 64; o <<= 1) { mq = fmaxf(mq, __shfl_xor(mq, o)); mk = fmaxf(mk, __shfl_xor(mk, o)); dq = fmaxf(dq, __shfl_xor(dq, o)); dk = fmaxf(dk, __shfl_xor(dk, o)); }
                if (F.lane < 16) {
                    const int s = F.lane; const bool moba = s < 8;
                    const float SB = 64.0f * pg8::C2Q * 1.02f * (moba ? mq * mk : dq * dk);
                    const float slope = moba ? exp2f(-(float)(s + 1)) : exp2f(-2.0f * (float)(((s - 8) >> 1) + 1));
                    const float a2 = 1.4426950408889634f * slope;
                    const float reach = (2.0f * SB + 40.0f) / a2;
                    float npf = ceilf(1.0f + (reach - 1.0f) * (1.0f / 64.0f));
                    npf = fminf(fmaxf(npf, 2.0f), 60.0f);
                    int np = (int)npf; np += (np & 1);
                    npast[l * 16 + s] = np;
                    ((float*)(args.ws + WS_NPAST + 1024))[l * 16 + s] = SB;
                }
            }
        }
    }
    if (gw == 2 * NWAVES) {
        float* pm = (float*)(args.ws + WS_PARM);
        float a1[DEPTH], b1[DEPTH], a2v[DEPTH], b2[DEPTH], s0[DEPTH], s1v[DEPTH];
#pragma unroll
        for (int l = 0; l < DEPTH; ++l) { a1[l] = args.in[7][l * 64 + F.lane]; b1[l] = args.in[8][l * 64 + F.lane]; a2v[l] = args.in[9][l * 64 + F.lane]; b2[l] = args.in[10][l * 64 + F.lane];
            s0[l] = args.in[11][l * 128 + F.lane]; s1v[l] = args.in[11][l * 128 + 64 + F.lane]; }
#pragma unroll
        for (int l = 0; l < DEPTH; ++l) {
            const float lam_init = (l == 0) ? 0.2f : 0.35550906759096926f;
            const float s1 = wave_sum(a1[l] * b1[l]), s2 = wave_sum(a2v[l] * b2[l]);
            if (F.lane == 0) pm[PARM_LAMV + l] = __expf(s1) - __expf(s2) + lam_init;
            pm[PARM_SW + l * 128 + F.lane] = s0[l] * (1.0f - lam_init); pm[PARM_SW + l * 128 + 64 + F.lane] = s1v[l] * (1.0f - lam_init); }
    }
    constexpr int I_IN = (D / 16) * (INW / 128), I_OUT = (D / 16) * (D / 128);
    bf16* win = (bf16*)(args.ws + WS_WIN);
#ifdef PROBE_P0_T
    unsigned tp0_ = (unsigned)__builtin_amdgcn_s_memrealtime();
#endif
    for (int it = gw; it < I_IN; it += NGW) p0_transpose_item<true>(args.in[2], D, INW, win, scr, it, F.lane, args.in[1]);
#ifdef PROBE_P0_T
    { const unsigned tn_ = (unsigned)__builtin_amdgcn_s_memrealtime(); if (F.wave == 0 && F.lane == 0) ((volatile LAS unsigned*)(F.lds + MISC_OFF))[41] += tn_ - tp0_; tp0_ = tn_; }
#endif
    const float* x = args.in[0];
    bf16* XN = (bf16*)(args.ws + WS_XN); float* ssq = (float*)(args.ws + WS_SSQ);
    for (int m0 = gw; m0 < M; m0 += 4 * NGW) {
        f32x4 v[4][4]; float s[4];
#pragma unroll
        for (int k = 0; k < 4; ++k) { const int m = m0 + k * NGW; const GAS f32x4* xr = (const GAS f32x4*)(x + (size_t)(m < M ? m : gw) * D) + F.lane;
#pragma unroll
            for (int j = 0; j < 4; ++j) v[k][j] = xr[64 * j]; }
#pragma unroll
        for (int k = 0; k < 4; ++k) { float t = 0.f;
#pragma unroll
            for (int j = 0; j < 4; ++j) t += (v[k][j].x * v[k][j].x + v[k][j].y * v[k][j].y) + (v[k][j].z * v[k][j].z + v[k][j].w * v[k][j].w);
            s[k] = wave_sum(t); }
#pragma unroll
        for (int k = 0; k < 4; ++k) { const int m = m0 + k * NGW; if (m < M) {
            GAS unsigned long long* o8 = (GAS unsigned long long*)(XN + (size_t)m * D) + F.lane;
#pragma unroll
            for (int j = 0; j < 4; ++j) { const f32x4 y = v[k][j]; o8[64 * j] = (unsigned long long)pk2(y.x, y.y) | ((unsigned long long)pk2(y.z, y.w) << 32); }
            if (F.lane < 16) ssq[(size_t)m * 16 + F.lane] = (F.lane == 0) ? s[k] : 0.f; } }
    }
#ifdef PROBE_P0_T
    { const unsigned tn_ = (unsigned)__builtin_amdgcn_s_memrealtime(); if (F.wave == 0 && F.lane == 0) ((volatile LAS unsigned*)(F.lds + MISC_OFF))[42] += tn_ - tp0_; }
#endif
}

__device__ __forceinline__ void convert_rest(Frame& FF, const Args& args) {
    const int t = phase_tid(FF.wave), lane = t & 63;
    LAS float* scr = (LAS float*)(FF.lds + RING_OFF + FF.wave * 16384);
    constexpr int I_IN = (D / 16) * (INW / 128), I_OUT = (D / 16) * (D / 128), NREST = (DEPTH - 1) * I_IN + DEPTH * I_OUT;
    bf16* win = (bf16*)(args.ws + WS_WIN); bf16* wout = (bf16*)(args.ws + WS_WOUT);
    gu32* head = FF.ctl + CW_CVTQ;
    for (int par = 0;; par ^= 1) {
        if (t == 0) FF.MISC[24 + par] = __hip_atomic_fetch_add(head, 1u, RLX_AGENT);
        __syncthreads();
        const int tk = (int)FF.MISC[24 + par];
        if (tk * NWAVES >= NREST) break;
        int r = tk * NWAVES + FF.wave;
        {
        if (r < (DEPTH - 1) * I_IN) { const int l = 1 + r / I_IN; r %= I_IN; p0_transpose_item<true>(args.in[2] + (size_t)l * D * INW, D, INW, win + (size_t)l * INW * D, scr, r, lane, args.in[1] + l * D); }
        else { r -= (DEPTH - 1) * I_IN;
        { const int l = r / I_OUT; r -= l * I_OUT; p0_transpose_item<false>(args.in[12] + (size_t)l * D * D, D, D, wout + (size_t)l * D * D, scr, r, lane, nullptr); }
        }
        }
    }
}

constexpr int ATT_QLEN = 12 * 16;
__device__ __forceinline__ void attn_make_unit(const Args& args, int layer, int b, int idx, int comp, attn_body::UnitDesc& U, bool& isdiff) {
    const int qb = 15 - idx / 12, st = idx % 12;
    U.qb = qb; isdiff = st < 4;
    const int nps = ((const int*)(args.ws + WS_NPAST))[layer * 16 + (isdiff ? 8 + 2 * st : st - 4)];
    U.np = (4 * qb < nps) ? 4 * qb : nps;
    const float sb_ = ((const float*)(args.ws + WS_NPAST + 1024))[layer * 16 + (isdiff ? 8 + 2 * st : st - 4)];
    const attn_body::bf16* proj = (const attn_body::bf16*)(args.ws + WS_PROJ);
    const size_t TS = (size_t)M * 512, rb = (size_t)b * SEQ;
    if (!isdiff) {
        const int vh = st - 4;
        U.Q = proj + 0 * TS + rb * 512 + vh * 64; U.K = proj + 1 * TS + rb * 512 + vh * 64; U.V = proj + 2 * TS + rb * 512 + vh * 64; U.G = proj + 3 * TS + rb * 512 + vh * 64;
        U.O = (attn_body::bf16*)(args.ws + WS_MIX) + rb * 1024 + vh * 64;
        U.KM = (const float*)(args.ws + WS_KMEAN) + (size_t)(b * 8 + vh) * 16 * 2 * 64;
        U.a2 = 1.4426950408889634f * __builtin_amdgcn_exp2f(-(float)(vh + 1)); U.sbc = sb_ + 63.0f * U.a2;
        U.mode = 0; U.O1 = nullptr; U.SW = nullptr; U.lam = 0.f;
    } else {
        const int h = st, hc = 2 * h + comp;
        U.Q = proj + 4 * TS + rb * 512 + hc * 64; U.K = proj + 5 * TS + rb * 512 + hc * 64; U.V = proj + 6 * TS + rb * 512 + h * 128; U.G = proj + 7 * TS + rb * 512 + h * 128;
        U.O = (attn_body::bf16*)(args.ws + WS_MIX) + rb * 1024 + 512 + h * 128;
        U.KM = nullptr;
        U.a2 = 1.4426950408889634f * __builtin_amdgcn_exp2f(-2.0f * (float)(h + 1)); U.sbc = sb_ + 63.0f * U.a2;
        U.mode = 1 + comp; U.O1 = (float*)(args.ws + WS_OD) + (size_t)blockIdx.x * 32768;
        const float* pm = (const float*)(args.ws + WS_PARM); U.SW = pm + PARM_SW + layer * 128; U.lam = pm[PARM_LAMV + layer];
    }
}

__device__ __forceinline__ void attn_next_ptrs(const Args& args, int b, int idx, int comp, const attn_body::bf16*& pk, const attn_body::bf16*& pq) {
    const int qb = 15 - idx / 12, st = idx % 12;
    const attn_body::bf16* proj = (const attn_body::bf16*)(args.ws + WS_PROJ);
    const size_t TS = (size_t)M * 512, rb = (size_t)b * SEQ + (size_t)qb * 256;
    if (st >= 4) { const int vh = st - 4; pq = proj + 0 * TS + rb * 512 + vh * 64; pk = proj + 1 * TS + rb * 512 + vh * 64; }
    else { const int hc = 2 * st + comp; pq = proj + 4 * TS + rb * 512 + hc * 64; pk = proj + 5 * TS + rb * 512 + hc * 64; }
}

__device__ __forceinline__ void touch_xn_tiles(Frame& F, const Args& args) {
    const int t = phase_tid(F.wave), lane = t & 63;
    pg8::StaticOrder S; S.init(M, D, F.G, (int)blockIdx.x); pg8::Unit u;
    const attn_body::bf16* XN = (const attn_body::bf16*)(args.ws + WS_XN);
    const unsigned ldsb = (unsigned)(uintptr_t)(unsigned char*)(F.lds + RING_OFF) + (unsigned)F.wave * 16384u;
    for (int i = 0; S.next(i, u); ++i) {
        const attn_body::bf16* src = XN + (size_t)(u.pm * 256 + F.wave * 32 + (lane >> 5)) * 1024 + u.pn * 256 + (lane & 31) * 8;
#pragma unroll
        for (int p = 0; p < 16; ++p) attn_body::glds16(src + (size_t)(2 * p) * 1024, (unsigned)__builtin_amdgcn_readfirstlane(ldsb + (unsigned)p * 1024u));
        asm volatile("s_waitcnt vmcnt(0)" ::: "memory");
    }
}

__global__ void __launch_bounds__(NWAVES * 64, 2) mk_fwd(Args args) {
    extern __shared__ __attribute__((aligned(16))) unsigned char lds[];
    Frame F;
    F.lds = (LAS unsigned char*)lds;
    F.MISC = (volatile LAS unsigned*)(F.lds + MISC_OFF);
    F.wave = __builtin_amdgcn_readfirstlane((int)threadIdx.x >> 6);
    F.G = gridDim.x; { const int bx = blockIdx.x; F.vcu = (F.G % 8 == 0) ? (bx % 8) * (F.G / 8) + bx / 8 : bx; }
    unsigned char* ws = args.ws;
    F.ctl = (gu32*)(ws + WS_CTL);
    for (int u = threadIdx.x; u < (LDS_BYTES - LDSCTL_OFF) / 4; u += NWAVES * 64) ((LAS unsigned*)(F.lds + LDSCTL_OFF))[u] = 0u;
    __syncthreads();
    XcdBarrier bar; bar.bar = (unsigned*)(F.ctl + CW_BAR); bar.x = 0; bar.st = nullptr;
    if (!MK_PER_PHASE) bar = xcd_barrier_post((unsigned*)(F.ctl + CW_BAR), F.MISC + 8, (int)threadIdx.x);
#define GRID_BAR() do { if (MK_PER_PHASE) { if (phase_tid(F.wave) == 0) __hip_atomic_store(F.ctl + CW_TMO, 0xBADBA0u, RLX_AGENT); } else { xcd_barrier(bar, phase_tid(F.wave)); } } while (0)
#ifdef PROBE_TIME
    int n_stamp = 0;
#define STAMP() do { if (phase_tid(F.wave) == 0) F.MISC[20 + n_stamp] = (unsigned)__builtin_amdgcn_s_memrealtime(); ++n_stamp; } while (0)
#else
#define STAMP() do {} while (0)
#endif
    STAMP();
    const int lo = args.ph_lo, hi = args.ph_hi;
#define IN(k) (lo <= (k) && (k) < hi)
#define BOTH(k) (IN(k) && IN((k) + 1))

#ifndef DUP_PHASE
#define DUP_PHASE -1
#endif
#ifndef NO_P0
    if (IN(0)) { p0_prologue(F, args); if (DUP_PHASE == 0) { GRID_BAR(); p0_prologue(F, args); } if (BOTH(0)) GRID_BAR(); STAMP(); }
#endif

    for (int layer = 0; layer < DEPTH; ++layer) {
        const int pb = 1 + 3 * layer;
        for (int rep = 0; rep < ((DUP_PHASE == 1 && layer == 0) ? 2 : 1); ++rep)
        if (IN(pb)) {
#ifndef SKEW_P1_TICKS
#define SKEW_P1_TICKS 0
#endif
            if (SKEW_P1_TICKS > 0 && (F.vcu & 1)) { const unsigned long long t0_ = __builtin_amdgcn_s_memrealtime(); while (__builtin_amdgcn_s_memrealtime() - t0_ < (unsigned long long)SKEW_P1_TICKS) __builtin_amdgcn_s_sleep(16); }
            pg8::Gemm g{(const pg8::bf16_t*)(ws + WS_XN), (const pg8::bf16_t*)(ws + WS_WIN) + (size_t)layer * INW * D, M, INW, D};
            pg8::StaticOrder S; S.init(M, INW, F.G, (int)blockIdx.x);
            pg8::EpiProj E{(pg8::bf16_t*)(ws + WS_PROJ), (const float*)(ws + WS_SSQ), (const float*)(ws + WS_NORMW) + layer * 256, (float*)(ws + WS_KMEAN), args.nrep
#ifdef PROBE_EPI_T
                , F.MISC + 40
#endif
            };
#ifndef NO_PROJ
            pg8::gemm_phase<pg8::EpiProj, pg8::StaticOrder, PG8_ALIGN, PG8_SP2>(F.lds + RING_OFF, g, S, E, phase_tid(F.wave));
#endif
            if (BOTH(pb)) GRID_BAR(); STAMP();
        }
        for (int rep = 0; rep < ((DUP_PHASE == 2 && layer == 0) ? 2 : 1); ++rep)
        if (IN(pb + 1)) {
            attn_body::UnitDesc U;
#ifndef NO_ATTN
            const int atid = phase_tid(F.wave);
            const int myq = (int)(xb_xcc_id() & 7u);
            gu32* qh = F.ctl + CW_ATTQ + ((layer * 2 + rep) * 8) * 64;
            int par = 0;
            for (int qi = 0; qi < 8; ++qi) {
                const int q = (myq + qi) & 7;
                if (atid == 0) F.MISC[16 + par] = __hip_atomic_fetch_add(qh + q * 64, 1u, RLX_AGENT);
                __syncthreads();
                int pre = 0;
                for (;;) {
                    const int idx = (int)F.MISC[16 + par]; par ^= 1;
                    if (idx >= ATT_QLEN) break;
                    for (int comp = 0; comp < 2; ++comp) {
                        bool isdiff; attn_make_unit(args, layer, q, idx, comp, U, isdiff);
                        const bool lastpass = !isdiff || comp == 1;
                        U.qnext = lastpass ? (unsigned*)(qh + q * 64) : nullptr; U.qslot = (MISC_OFF - RING_OFF) + (16 + par) * 4;
                        U.pre = pre; U.pfK = nullptr; U.pfQ = nullptr; U.pfq2 = 0; pre = 0;
                        if (!lastpass) { attn_next_ptrs(args, q, idx, 1, U.pfK, U.pfQ); U.pfq2 = 1; pre = 1; }
                        if (isdiff) attn_body::attn_unit<8, 2>(U, (char*)lds + RING_OFF, atid);
                        else { attn_body::attn_unit<8, 1>(U, (char*)lds + RING_OFF, atid); break; }
                    }
                }
            }
#endif
            if (layer == 0) convert_rest(F, args);
            if (BOTH(pb + 1)) GRID_BAR(); STAMP();
        }
        if (IN(pb + 2)) {
            const int last = (layer == DEPTH - 1);
            pg8::Gemm g{(const pg8::bf16_t*)(ws + WS_MIX), (const pg8::bf16_t*)(ws + WS_WOUT) + (size_t)layer * D * D, M, D, D};
            pg8::StaticOrder S; S.init(M, D, F.G, (int)blockIdx.x);
#ifdef PROBE_TIME
            pg8::EpiOut E{(pg8::bf16_t*)(ws + WS_XN), args.out, (float*)(ws + WS_SSQ), last,
#ifdef PROBE_EPI_T
                F.MISC + 40,
#endif
                (const unsigned*)(ws + WS_NPAST + 4096), F.MISC + 20};
#else
            pg8::EpiOut E{(pg8::bf16_t*)(ws + WS_XN), args.out, (float*)(ws + WS_SSQ), last};
#endif
#ifndef NO_OUT
            pg8::gemm_phase<pg8::EpiOut, pg8::StaticOrder, PG8_ALIGN, PG8_SP2>(F.lds + RING_OFF, g, S, E, phase_tid(F.wave));
#endif
            if (BOTH(pb + 2)) GRID_BAR(); STAMP();
        }
    }
#undef IN
#undef BOTH
}

extern "C" void kernel_launch(void* const* d_in, const int* in_sizes, int n_in, void* d_out, int out_size, void* d_ws, size_t ws_size, hipStream_t stream) {
    static int grid = 0;
    if (grid == 0) {
        if (n_in != 13 || in_sizes[0] != M * D || out_size != M * D || ws_size < WS_END) { fprintf(stderr, "kernel_launch: unexpected shapes (n_in %d in0 %d out %d ws %zu); nothing launched\n", n_in, n_in > 0 ? in_sizes[0] : -1, out_size, ws_size); grid = -1; return; }
        int dev = 0, cus = 0, per_cu = 0;
        if (hipGetDevice(&dev) != hipSuccess || hipDeviceGetAttribute(&cus, hipDeviceAttributeMultiprocessorCount, dev) != hipSuccess) { grid = -1; return; }
        if (hipFuncSetAttribute((const void*)mk_fwd, hipFuncAttributeMaxDynamicSharedMemorySize, LDS_BYTES) != hipSuccess) { fprintf(stderr, "kernel_launch: hipFuncSetAttribute failed\n"); grid = -1; return; }
        if (hipOccupancyMaxActiveBlocksPerMultiprocessor(&per_cu, (const void*)mk_fwd, NWAVES * 64, LDS_BYTES) != hipSuccess || per_cu < 1)
            fprintf(stderr, "kernel_launch: note: occupancy query reports %d workgroups per CU\n", per_cu);
        (void)hipGetLastError();
        grid = cus;
    }
    if (grid < 0) return;
    if (hipMemsetAsync((char*)d_ws + WS_CTL, 0, CTL_ZERO_BYTES, stream) != hipSuccess) return;
    Args a{};
    for (int i = 0; i < 13; ++i) a.in[i] = (const float*)d_in[i];
    a.out = (float*)d_out; a.ws = (unsigned char*)d_ws;
#ifdef PROBE_EPI2
    a.nrep = 2;
#else
    a.nrep = 1;
#endif
#if MK_PER_PHASE
    for (int p = 0; p < N_PHASES; ++p) { a.ph_lo = p; a.ph_hi = p + 1; hipLaunchKernelGGL(mk_fwd, dim3(grid), dim3(NWAVES * 64), LDS_BYTES, stream, a); }
#else
    a.ph_lo = 0; a.ph_hi = N_PHASES;
    hipLaunchKernelGGL(mk_fwd, dim3(grid), dim3(NWAVES * 64), LDS_BYTES, stream, a);
#endif
    const hipError_t le = hipPeekAtLastError();
    if (le != hipSuccess) fprintf(stderr, "kernel_launch: launch failed: %s (grid %d)\n", hipGetErrorName(le), grid);
}
```

```cpp
#include <hip/hip_runtime.h>
#include <cstdio>
#include <cstdint>
namespace pg8 {
#define PG8_LAS __attribute__((address_space(3)))
typedef unsigned short bf16_t;
typedef short bf16x8 __attribute__((ext_vector_type(8)));
typedef float f32x4 __attribute__((ext_vector_type(4)));
typedef unsigned u32x4 __attribute__((ext_vector_type(4)));
constexpr int BM = 256, BK = 64, HALF = 128, HTB = HALF * BK * 2  , STAGE_BYTES = 8 * HTB, NXCD = 8, WGM = 8;

__host__ __device__ __forceinline__ int lds_byte(int r, int c) { const int st = (r >> 4) * 2 + (c >> 5), rr = r & 15, cc = c & 31, ob = rr * 64 + cc * 2; return st * 1024 + (ob ^ (((ob >> 9) & 1) << 5)); }
__host__ __device__ __forceinline__ void stage_rc(int b, int& R, int& C) { const int st = b / 1024, sb = b % 1024, swz = sb ^ (((sb >> 9) & 1) << 5); R = (st >> 1) * 16 + swz / 64; C = (st & 1) * 32 + (swz % 64) / 2; }
__host__ __device__ __forceinline__ int perm32(int rho) { const int n = rho >> 4, i = rho & 15; return 8 * (i >> 2) + 4 * n + (i & 3); }

struct Unit { int pm, pn; };
struct Gemm { const bf16_t* A; const bf16_t* Bt; int M, N, K; };

struct StaticOrder {
    int nM, nN, nwg, G, c;
    __host__ __device__ void init(int M, int N, int G_, int c_) { nM = M / BM; nN = N / BM; nwg = nM * nN; G = G_; c = c_; }
    __host__ __device__ bool next(int i, Unit& u) const {
        const long L = (long)i * G + c; if (L >= nwg) return false;
        int wgid = (int)L; { const int q = nwg / NXCD, r = nwg % NXCD, xcd = wgid % NXCD, off = wgid / NXCD; wgid = (xcd < r ? xcd * (q + 1) : r * (q + 1) + (xcd - r) * q) + off; }
        const int nig = WGM * nN, gid = wgid / nig, fm = gid * WGM, gsz = (nM - fm) < WGM ? (nM - fm) : WGM;
        u.pm = fm + ((wgid % nig) % gsz); u.pn = (wgid % nig) / gsz; return true;
    }
    __device__ __forceinline__ void a_ready(const Unit&) const {}
    __device__ __forceinline__ void done(const Unit&) const {}
};

struct SingleOrder {
    Unit u;
    __device__ __forceinline__ bool next(int i, Unit& o) const { if (i != 0) return false; o = u; return true; }
    __device__ __forceinline__ void a_ready(const Unit&) const {}
    __device__ __forceinline__ void done(const Unit&) const {}
};

__device__ __forceinline__ unsigned cvt_pk_bf16(float lo, float hi) { unsigned r; asm volatile("v_cvt_pk_bf16_f32 %0, %1, %2" : "=v"(r) : "v"(lo), "v"(hi)); return r; }
typedef float f32x2 __attribute__((ext_vector_type(2)));
#ifndef WT_STORES
#define WT_STORES 0
#endif
#if WT_STORES
#define ST16_WT(p, v) asm volatile("global_store_dwordx4 %0, %1, off sc1\n\ts_nop 1" :: "v"(p), "v"(v) : "memory")
#else
#define ST16_WT(p, v) (*(u32x4*)(p) = (v))
#endif
constexpr int PM_ROWS = 32768;
constexpr float C2Q = 0.125f * 1.4426950408889634f;
struct EpiProj {
    static constexpr bool PERM = true, AFTER_DRAIN = false;
    bf16_t* proj;
    const float* ssq;
    const float* normw;
    float* kmean;
    int nrep;
#ifdef PROBE_EPI_T
    static constexpr bool TIMED = (PROBE_EPI_T == 1); volatile PG8_LAS unsigned* tacc;
#endif
    static constexpr int NST0 = 16, NST1 = 20;
    __device__ __forceinline__ int nstores(const Unit& u) const { return (u.pn >> 1) == 1 ? NST1 : NST0; }
    static __device__ __forceinline__ float sum_fq(float x) {
        auto a = __builtin_amdgcn_permlane16_swap(__float_as_uint(x), __float_as_uint(x), false, false); x = __uint_as_float(a[0]) + __uint_as_float(a[1]);
        auto b = __builtin_amdgcn_permlane32_swap(__float_as_uint(x), __float_as_uint(x), false, false); return __uint_as_float(b[0]) + __uint_as_float(b[1]); }
    static __device__ __forceinline__ float sum_fr(float x) {
        x += __builtin_bit_cast(float, __builtin_amdgcn_update_dpp(0, __builtin_bit_cast(int, x), 0xB1, 0xF, 0xF, true));
        x += __builtin_bit_cast(float, __builtin_amdgcn_update_dpp(0, __builtin_bit_cast(int, x), 0x4E, 0xF, 0xF, true));
        x += __builtin_bit_cast(float, __builtin_amdgcn_update_dpp(0, __builtin_bit_cast(int, x), 0x141, 0xF, 0xF, true));
        x += __builtin_bit_cast(float, __builtin_amdgcn_update_dpp(0, __builtin_bit_cast(int, x), 0x140, 0xF, 0xF, true));
        return x; }
    __device__ __forceinline__ void rows_qk(const bool KM, const f32x4 (&acc)[2][2][4][2], bf16_t* base, const float (&rinv)[8], const f32x4 (&wv)[2][2], const Unit& u, int row0, int col0, int wr, int wc, int fr, int fq) const {
        f32x4 ks[2][2];
#pragma unroll
        for (int bj = 0; bj < 2; ++bj)
#pragma unroll
            for (int n = 0; n < 2; ++n) ks[bj][n] = (f32x4){0.f, 0.f, 0.f, 0.f};
#pragma unroll
        for (int ai = 0; ai < 2; ++ai)
#pragma unroll
            for (int m = 0; m < 4; ++m) {
                const int row = row0 + ai * HALF + m * 16;
                f32x2 s2 = {0.f, 0.f};
#pragma unroll
                for (int bj = 0; bj < 2; ++bj)
#pragma unroll
                    for (int n = 0; n < 2; ++n) { const f32x4 a = acc[ai][bj][m][n]; const f32x2 lo = {a[0], a[1]}, hi2 = {a[2], a[3]};
                        s2 = __builtin_elementwise_fma(lo, lo, s2); s2 = __builtin_elementwise_fma(hi2, hi2, s2); }
                const float ss = sum_fq(s2[0] + s2[1]);
                const float r = rinv[ai * 4 + m];
                const float s1 = r * __builtin_amdgcn_rsqf(ss * (r * r) * (1.0f / 64.0f) + 1e-6f);
                f32x4 v[2][2];
#pragma unroll
                for (int bj = 0; bj < 2; ++bj)
#pragma unroll
                    for (int n = 0; n < 2; ++n) v[bj][n] = acc[ai][bj][m][n] * s1 * wv[bj][n];
                if (KM) { asm volatile("");
#pragma unroll
                    for (int bj = 0; bj < 2; ++bj)
#pragma unroll
                        for (int n = 0; n < 2; ++n) ks[bj][n] += v[bj][n]; }
                bf16_t* rowp = base + (size_t)row * 512 + col0;
#pragma unroll
                for (int bj = 0; bj < 2; ++bj) { u32x4 w4; w4.x = cvt_pk_bf16(v[bj][0][0], v[bj][0][1]); w4.y = cvt_pk_bf16(v[bj][0][2], v[bj][0][3]); w4.z = cvt_pk_bf16(v[bj][1][0], v[bj][1][1]); w4.w = cvt_pk_bf16(v[bj][1][2], v[bj][1][3]);
                    ST16_WT(rowp + 32 * bj, w4); }
                asm volatile("" ::: "memory"); __builtin_amdgcn_sched_barrier(0);
            }
        if (KM) {
#pragma unroll
            for (int bj = 0; bj < 2; ++bj)
#pragma unroll
                for (int n = 0; n < 2; ++n)
#pragma unroll
                    for (int j = 0; j < 4; ++j) ks[bj][n][j] = sum_fr(ks[bj][n][j]);
            if (fr == 0) {
                const int b = u.pm >> 4, blk = u.pm & 15, h = (u.pn & 1) * 4 + wc;
                float* kp = kmean + ((size_t)((b * 8 + h) * 16 + blk) * 2 + wr) * 64 + 8 * fq;
#pragma unroll
                for (int bj = 0; bj < 2; ++bj)
#pragma unroll
                    for (int n = 0; n < 2; ++n) *(f32x4*)(kp + 32 * bj + 4 * n) = ks[bj][n];
            }
        }
    }
    struct Pre {}; struct State { f32x4 ra, rb; int pm; };
    __device__ __forceinline__ void begin(State& st) const { st.pm = -1; st.ra = (f32x4){0.f, 0.f, 0.f, 0.f}; st.rb = st.ra; }
    __device__ __forceinline__ void pre_load(Pre&, const Unit&, int, int, int, int) const {}
    __device__ __forceinline__ void pre_none(Pre&) const {}
    __device__ __forceinline__ void pre_apply(f32x4 (&acc)[2][2][4][2], const Pre&) const {
#pragma unroll
        for (int a = 0; a < 2; ++a)
#pragma unroll
            for (int b = 0; b < 2; ++b)
#pragma unroll
                for (int m = 0; m < 4; ++m)
#pragma unroll
                    for (int n = 0; n < 2; ++n) acc[a][b][m][n] = (f32x4){0.f, 0.f, 0.f, 0.f};
    }
    __device__ __forceinline__ void operator()(const f32x4 (&acc)[2][2][4][2], const Unit& u, int wr, int wc, int fr, int fq, State& st) const {
        asm volatile("" : "+v"(fr), "+v"(fq));
        const int mode = u.pn >> 1;
        bf16_t* base = proj + (size_t)mode * PM_ROWS * 512;
        const int col0 = (u.pn & 1) * 256 + wc * 64 + 8 * fq;
        const int row0 = u.pm * BM + wr * 64 + fr;
        const bool isqk = (mode & 2) == 0, isg = (mode & 3) == 3, iskm = (mode == 1);
        f32x4 wv[2][2];
        if (isqk) {
            const float* w = normw + (((mode >> 2) * 2 + (mode & 1)) * 64);
            const float sc = (mode & 1) ? 1.0f : C2Q;
#pragma unroll
            for (int bj = 0; bj < 2; ++bj)
#pragma unroll
                for (int n = 0; n < 2; ++n) wv[bj][n] = *(const f32x4*)(w + 32 * bj + 8 * fq + 4 * n) * sc;
        }
        float rinv[8];
        if (st.pm != u.pm) { st.pm = u.pm; f32x4 sq[8];
#pragma unroll
          for (int q = 0; q < 8; ++q) sq[q] = *(const f32x4*)(ssq + (size_t)(row0 + (q >> 2) * HALF + (q & 3) * 16) * 16 + 4 * fq);
#pragma unroll
          for (int q = 0; q < 8; ++q) { float tot = (sq[q][0] + sq[q][1]) + (sq[q][2] + sq[q][3]); tot = sum_fq(tot); rinv[q] = __builtin_amdgcn_rsqf(tot * (1.0f / 1024.0f) + 1e-6f); }
          st.ra = (f32x4){rinv[0], rinv[1], rinv[2], rinv[3]}; st.rb = (f32x4){rinv[4], rinv[5], rinv[6], rinv[7]}; }
        else {
#pragma unroll
          for (int q = 0; q < 4; ++q) { rinv[q] = st.ra[q]; rinv[4 + q] = st.rb[q]; } }
        if (isqk) {
            rows_qk(iskm, acc, base, rinv, wv, u, row0, col0, wr, wc, fr, fq);
        } else {
#pragma unroll
            for (int ai = 0; ai < 2; ++ai)
#pragma unroll
                for (int m = 0; m < 4; ++m) {
                    const int row = row0 + ai * HALF + m * 16;
                    f32x4 v[2][2];
#pragma unroll
                    for (int bj = 0; bj < 2; ++bj)
#pragma unroll
                        for (int n = 0; n < 2; ++n) v[bj][n] = acc[ai][bj][m][n] * rinv[ai * 4 + m];
                    if (isg) {
#pragma unroll
                        for (int bj = 0; bj < 2; ++bj)
#pragma unroll
                            for (int n = 0; n < 2; ++n)
#pragma unroll
                                for (int j = 0; j < 4; ++j) { const float x = v[bj][n][j]; v[bj][n][j] = x * __builtin_amdgcn_rcpf(1.0f + __builtin_amdgcn_exp2f(-1.4426950408889634f * x)); }
                    }
                    bf16_t* rowp = base + (size_t)row * 512 + col0;
#pragma unroll
                    for (int bj = 0; bj < 2; ++bj) { u32x4 w4; w4.x = cvt_pk_bf16(v[bj][0][0], v[bj][0][1]); w4.y = cvt_pk_bf16(v[bj][0][2], v[bj][0][3]); w4.z = cvt_pk_bf16(v[bj][1][0], v[bj][1][1]); w4.w = cvt_pk_bf16(v[bj][1][2], v[bj][1][3]);
                        ST16_WT(rowp + 32 * bj, w4); }
                    asm volatile("" ::: "memory");
                }
        }
    }
};
struct EpiOut {
    static constexpr bool PERM = true, AFTER_DRAIN = false;
    bf16_t* xn; float* out; float* ssq; int last;
#ifdef PROBE_EPI_T
    static constexpr bool TIMED = (PROBE_EPI_T == 2); volatile PG8_LAS unsigned* tacc;
#endif
#ifdef PROBE_TIME
    const unsigned* busy;
    volatile PG8_LAS unsigned* stamps;
#endif
    static constexpr int NST0 = 24, NST1 = 32;
    __device__ __forceinline__ int nstores(const Unit&) const { return last ? NST1 : NST0; }
    struct Pre { u32x4 bs[2][4][2]; }; struct State {};
    __device__ __forceinline__ void begin(State&) const {}
    __device__ __forceinline__ void pre_load(Pre& p, const Unit& u, int wr, int wc, int fr, int fq) const {
        const int col0 = u.pn * BM + wc * 32 + 8 * fq;
#pragma unroll
        for (int ai = 0; ai < 2; ++ai)
#pragma unroll
            for (int m = 0; m < 4; ++m)
#pragma unroll
                for (int bj = 0; bj < 2; ++bj) p.bs[ai][m][bj] = *(const u32x4*)(xn + (size_t)(u.pm * BM + ai * HALF + wr * 64 + m * 16 + fr) * 1024 + col0 + bj * HALF);
    }
    __device__ __forceinline__ void pre_none(Pre& p) const {
#pragma unroll
        for (int ai = 0; ai < 2; ++ai)
#pragma unroll
            for (int m = 0; m < 4; ++m)
#pragma unroll
                for (int bj = 0; bj < 2; ++bj) p.bs[ai][m][bj] = (u32x4){0u, 0u, 0u, 0u};
    }
    __device__ __forceinline__ void pre_apply(f32x4 (&acc)[2][2][4][2], const Pre& p) const {
#pragma unroll
        for (int ai = 0; ai < 2; ++ai)
#pragma unroll
            for (int m = 0; m < 4; ++m)
#pragma unroll
                for (int bj = 0; bj < 2; ++bj) { const u32x4 b = p.bs[ai][m][bj];
                    acc[ai][bj][m][0] = (f32x4){__uint_as_float(b.x << 16), __uint_as_float(b.x & 0xffff0000u), __uint_as_float(b.y << 16), __uint_as_float(b.y & 0xffff0000u)};
                    acc[ai][bj][m][1] = (f32x4){__uint_as_float(b.z << 16), __uint_as_float(b.z & 0xffff0000u), __uint_as_float(b.w << 16), __uint_as_float(b.w & 0xffff0000u)}; }
    }
    __device__ __forceinline__ void operator()(const f32x4 (&acc)[2][2][4][2], const Unit& u, int wr, int wc, int fr, int fq, State&) const {
        const int col0 = u.pn * BM + wc * 32 + 8 * fq;
#pragma unroll
        for (int ai = 0; ai < 2; ++ai)
#pragma unroll
            for (int m = 0; m < 4; ++m) {
                const int row = u.pm * BM + ai * HALF + wr * 64 + m * 16 + fr; const size_t off = (size_t)row * 1024 + col0;
                float ss = 0.f;
#pragma unroll
                for (int bj = 0; bj < 2; ++bj) {
                    f32x4 o0 = acc[ai][bj][m][0], o1 = acc[ai][bj][m][1];
#ifdef PROBE_TIME
                    if (last && row == 0 && col0 == 0 && bj == 0) {
                        const unsigned now = (unsigned)__builtin_amdgcn_s_memrealtime(); const unsigned t0 = stamps[0], ta = stamps[PROBE_TIME], tb = stamps[PROBE_TIME + 1];
#if defined(PROBE_BUSY)
                        { const unsigned* bt = busy; unsigned mx = 0u, mn = 0xffffffffu; float sm = 0.f;
                          for (int i = 0; i < 256; ++i) { const unsigned v = bt[i]; mx = v > mx ? v : mx; mn = v < mn ? v : mn; sm += (float)v; }
                          const float val = (PROBE_BUSY == 0) ? sm * (1.0f / 256.0f) : (PROBE_BUSY == 1 ? (float)mx : (float)mn);
                          const float f = val / (float)(now - t0); o0[0] += 51.3f * sqrtf(f); } }
#elif defined(PROBE_ATT_T)
                        const float f = (float)stamps[20 + PROBE_ATT_T] / (float)(now - t0); o0[0] += 51.3f * sqrtf(f); }
#elif defined(PROBE_EPI_T)
                        const float f = (float)stamps[20] / (float)(now - t0); o0[0] += 51.3f * sqrtf(f); }
#else
                        const float f = (float)(tb - ta) / (float)(now - t0); o0[0] += 51.3f * sqrtf(f); }
#endif
#endif
                    if (last) { *(f32x4*)(out + off + bj * HALF) = o0; *(f32x4*)(out + off + bj * HALF + 4) = o1; }
                    else { ss += ((o0[0] * o0[0] + o0[1] * o0[1]) + (o0[2] * o0[2] + o0[3] * o0[3])) + ((o1[0] * o1[0] + o1[1] * o1[1]) + (o1[2] * o1[2] + o1[3] * o1[3]));
                        u32x4 w; w.x = cvt_pk_bf16(o0[0], o0[1]); w.y = cvt_pk_bf16(o0[2], o0[3]); w.z = cvt_pk_bf16(o1[0], o1[1]); w.w = cvt_pk_bf16(o1[2], o1[3]);
                        *(u32x4*)(xn + off + bj * HALF) = w; }
                }
                if (!last) { ss = EpiProj::sum_fq(ss); if (fq == 0) ssq[(size_t)row * 16 + u.pn * 4 + wc] = ss; }
            }
    }
};
template <class Epi, class Sched, bool ALIGN_EPI = false, bool SP2 = false>
__device__ __forceinline__ void gemm_phase(PG8_LAS unsigned char* lds, const Gemm g, const Sched& S, const Epi& E, const int tid) {
    const int wid = __builtin_amdgcn_readfirstlane(tid >> 6), lane = tid & 63, wr = wid >> 2, wc = wid & 3, fr = lane & 15, fq = lane >> 4;
    constexpr int K = 1024, nt = K / BK;
    unsigned voffA[2], voffB[2];
#pragma unroll
    for (int i = 0; i < 2; ++i) { int R, C; stage_rc(tid * 16 + i * 8192, R, C); const int Rb = Epi::PERM ? ((R & ~31) + perm32(R & 31)) : R;
        voffA[i] = (unsigned)(R * K + C) * 2u; voffB[i] = (unsigned)(Rb * K + C) * 2u; }
    constexpr size_t kstep = (size_t)(BK * 2);
    constexpr size_t hstep = (size_t)HALF * K * 2;
    constexpr size_t tstep = 2 * hstep;
    const unsigned ldsw = (unsigned)wid * 1024u;
    const int aoff = lds_byte(wr * 64 + fr, fq * 8), boff = lds_byte(wc * 32 + fr, fq * 8);
#define PG8_SA(b, h) (((b) * 2 + (h)) * HTB)
#define PG8_SB(b, h) ((4 + (b) * 2 + (h)) * HTB)
#define PG8_STAGE(bufoff, gbase, voff) do { _Pragma("unroll") for (int _i = 0; _i < 2; ++_i) \
        __builtin_amdgcn_global_load_lds((const unsigned*)((const char*)(gbase) + (voff)[_i]), (PG8_LAS unsigned*)(lds + (bufoff) + ldsw + _i * 8192), 16, 0, 0); } while (0)
#define PG8_LDA(dst, b, h) do { _Pragma("unroll") for (int m = 0; m < 4; ++m) _Pragma("unroll") for (int k = 0; k < 2; ++k) dst[m][k] = *(const PG8_LAS bf16x8*)(lds + PG8_SA(b, h) + aoff + m * 2048 + k * 1024); } while (0)
#define PG8_LDB(dst, b, h) do { _Pragma("unroll") for (int n = 0; n < 2; ++n) _Pragma("unroll") for (int k = 0; k < 2; ++k) dst[n][k] = *(const PG8_LAS bf16x8*)(lds + PG8_SB(b, h) + boff + n * 2048 + k * 1024); } while (0)
#define PG8_MMA(ai, bj, At, Bt) do { __builtin_amdgcn_s_setprio(1); _Pragma("unroll") for (int m = 0; m < 4; ++m) _Pragma("unroll") for (int n = 0; n < 2; ++n) _Pragma("unroll") for (int k = 0; k < 2; ++k) \
        acc[ai][bj][m][n] = __builtin_amdgcn_mfma_f32_16x16x32_bf16(Bt[n][k], At[m][k], acc[ai][bj][m][n], 0, 0, 0); __builtin_amdgcn_s_setprio(0); } while (0)
#define PG8_WAIT_V(n) asm volatile("s_waitcnt vmcnt(" #n ")" ::: "memory")
#define PG8_WAIT_L(n) asm volatile("s_waitcnt lgkmcnt(" #n ")" ::: "memory")
#define PG8_BAR __builtin_amdgcn_s_barrier()
#define PG8_SCHED __builtin_amdgcn_sched_barrier(0)
#define PG8_WAIT_V8X do { if (__builtin_expect(xs != 0, 0)) { if (xs == Epi::NST0) PG8_WAIT_VN(8 + Epi::NST0); else PG8_WAIT_VN(8 + Epi::NST1); } else PG8_WAIT_V(8); } while (0)
#define PG8_WAIT_VN(n) asm volatile("s_waitcnt vmcnt(%0)" :: "n"(n) : "memory")
    Unit cur, nxt; int ui = 0; int xs = 0;
    if (!S.next(0, cur)) return;
    f32x4 acc[2][2][4][2];
    typename Epi::Pre pre; typename Epi::State est; E.begin(est);
    E.pre_load(pre, cur, wr, wc, fr, fq);
    bf16x8 At[4][2], B0[2][2], B1[2][2];
    const char* cA = (const char*)g.A + (size_t)cur.pm * tstep; const char* cB = (const char*)g.Bt + (size_t)cur.pn * tstep;
    S.a_ready(cur);
    if constexpr (SP2) {
        PG8_STAGE(PG8_SB(0, 0), cB, voffB); PG8_STAGE(PG8_SB(0, 1), cB + hstep, voffB); PG8_STAGE(PG8_SA(0, 0), cA, voffA); PG8_STAGE(PG8_SA(0, 1), cA + hstep, voffA);
        if (wr == 1) PG8_BAR;
        PG8_WAIT_V(2); PG8_BAR;
        PG8_STAGE(PG8_SB(1, 0), cB + kstep, voffB); PG8_STAGE(PG8_SA(1, 0), cA + kstep, voffA); PG8_STAGE(PG8_SB(1, 1), cB + hstep + kstep, voffB);
        PG8_WAIT_V(6); PG8_BAR;
    } else {
        PG8_STAGE(PG8_SB(0, 0), cB, voffB); PG8_STAGE(PG8_SA(0, 0), cA, voffA); PG8_STAGE(PG8_SB(0, 1), cB + hstep, voffB); PG8_STAGE(PG8_SA(0, 1), cA + hstep, voffA);
        if (wr == 1) PG8_BAR;
        PG8_WAIT_V(4); PG8_BAR;
        PG8_STAGE(PG8_SB(1, 0), cB + kstep, voffB); PG8_STAGE(PG8_SA(1, 0), cA + kstep, voffA); PG8_STAGE(PG8_SB(1, 1), cB + hstep + kstep, voffB);
        PG8_WAIT_V(6); PG8_BAR;
    }
    E.pre_apply(acc, pre);
    for (;;) {
        const bool has_next = S.next(ui + 1, nxt);
        const char* nA = has_next ? (const char*)g.A + (size_t)nxt.pm * tstep : cA; const char* nB = has_next ? (const char*)g.Bt + (size_t)nxt.pn * tstep : cB;
#pragma unroll 1
        for (int t = 0; t < nt; t += 2) {
            const bool last = (t == nt - 2);
            const char* a1 = cA + (size_t)(t + 1) * kstep;
            const char* a2 = last ? nA : cA + (size_t)(t + 2) * kstep; const char* b2 = last ? nB : cB + (size_t)(t + 2) * kstep;
            const char* a3 = a2 + kstep; const char* b3 = b2 + kstep;
            if (last && has_next) S.a_ready(nxt);
            if constexpr (SP2) {
            PG8_LDB(B0, 0, 0); PG8_LDB(B1, 0, 1); PG8_SCHED; PG8_LDA(At, 0, 0); if (xs == 0) PG8_STAGE(PG8_SA(1, 1), a1 + hstep, voffA);
            PG8_WAIT_V8X; PG8_WAIT_L(0); PG8_BAR; PG8_MMA(0, 0, At, B0); PG8_MMA(0, 1, At, B1); PG8_BAR; PG8_SCHED;
            PG8_LDA(At, 0, 1); PG8_STAGE(PG8_SB(0, 0), b2, voffB); PG8_STAGE(PG8_SB(0, 1), b2 + hstep, voffB); PG8_STAGE(PG8_SA(0, 0), a2, voffA);
            PG8_WAIT_V8X; PG8_WAIT_L(0); PG8_BAR; PG8_MMA(1, 0, At, B0); PG8_MMA(1, 1, At, B1); PG8_BAR; PG8_SCHED;
            PG8_LDB(B0, 1, 0); PG8_LDB(B1, 1, 1); PG8_SCHED; PG8_LDA(At, 1, 0); PG8_STAGE(PG8_SA(0, 1), a2 + hstep, voffA);
            PG8_WAIT_V8X; PG8_WAIT_L(0); PG8_BAR; PG8_MMA(0, 0, At, B0); PG8_MMA(0, 1, At, B1); PG8_BAR; PG8_SCHED; xs = 0;
            PG8_LDA(At, 1, 1); PG8_STAGE(PG8_SB(1, 0), b3, voffB); PG8_STAGE(PG8_SB(1, 1), b3 + hstep, voffB); PG8_STAGE(PG8_SA(1, 0), a3, voffA);
            PG8_WAIT_V(8); PG8_WAIT_L(0); PG8_BAR; PG8_MMA(1, 0, At, B0); PG8_MMA(1, 1, At, B1); PG8_BAR; PG8_SCHED;
            } else {
            PG8_LDB(B0, 0, 0); PG8_SCHED; PG8_LDA(At, 0, 0); PG8_STAGE(PG8_SA(1, 1), a1 + hstep, voffA);
            PG8_WAIT_L(8); PG8_BAR; PG8_WAIT_L(0); PG8_MMA(0, 0, At, B0); PG8_BAR; PG8_SCHED;
            PG8_LDB(B1, 0, 1); PG8_STAGE(PG8_SB(0, 0), b2, voffB);
            PG8_BAR; PG8_WAIT_L(0); PG8_MMA(0, 1, At, B1); PG8_BAR;
            PG8_LDA(At, 0, 1); PG8_STAGE(PG8_SA(0, 0), a2, voffA);
            PG8_BAR; PG8_WAIT_L(0); PG8_MMA(1, 0, At, B0); PG8_BAR; PG8_SCHED;
            PG8_STAGE(PG8_SB(0, 1), b2 + hstep, voffB);
            PG8_WAIT_V(6); PG8_BAR; PG8_MMA(1, 1, At, B1); PG8_BAR;
            PG8_LDB(B0, 1, 0); PG8_SCHED; PG8_LDA(At, 1, 0); PG8_STAGE(PG8_SA(0, 1), a2 + hstep, voffA);
            PG8_WAIT_L(8); PG8_BAR; PG8_WAIT_L(0); PG8_MMA(0, 0, At, B0); PG8_BAR; PG8_SCHED;
            PG8_LDB(B1, 1, 1); PG8_STAGE(PG8_SB(1, 0), b3, voffB);
            PG8_BAR; PG8_WAIT_L(0); PG8_MMA(0, 1, At, B1); PG8_BAR;
            PG8_LDA(At, 1, 1); PG8_STAGE(PG8_SA(1, 0), a3, voffA);
            PG8_BAR; PG8_WAIT_L(0); PG8_MMA(1, 0, At, B0); PG8_BAR; PG8_SCHED;
            PG8_STAGE(PG8_SB(1, 1), b3 + hstep, voffB);
            PG8_WAIT_V(6); PG8_BAR; PG8_MMA(1, 1, At, B1); PG8_BAR;
            }
        }
#ifdef PROBE_EPI_T
        unsigned te0_ = 0; if constexpr (Epi::TIMED) te0_ = (unsigned)__builtin_amdgcn_s_memrealtime();
#endif
        if constexpr (ALIGN_EPI) { if (wr == 0) PG8_BAR; }
        if constexpr (ALIGN_EPI && SP2) { if (has_next) { PG8_STAGE(PG8_SA(1, 1), nA + kstep + hstep, voffA); xs = E.nstores(cur); } }
        if constexpr (!Epi::AFTER_DRAIN) {
#ifdef PROBE_EPI2
            if constexpr (Epi::PERM) {
                _Pragma("unroll 1") for (int rep_ = 0; rep_ < E.nrep; ++rep_) { E(acc, cur, wr, wc, fr, fq, est); asm volatile("" ::: "memory"); }
            } else
#endif
            { if (has_next) E.pre_load(pre, nxt, wr, wc, fr, fq); else E.pre_none(pre);
              E(acc, cur, wr, wc, fr, fq, est); }
            S.done(cur); }
#ifdef PROBE_EPI_T
        if constexpr (Epi::TIMED) { if (tid == 0) { asm volatile("s_waitcnt vmcnt(0)" ::: "memory"); E.tacc[0] += (unsigned)__builtin_amdgcn_s_memrealtime() - te0_; } }
#endif
        if (!has_next) break;
        E.pre_apply(acc, pre);
        cur = nxt; cA = nA; cB = nB; ++ui;
        if constexpr (ALIGN_EPI) { if (wr == 1) PG8_BAR; }
    }
    PG8_WAIT_V(0);
    if constexpr (!ALIGN_EPI) { if (wr == 0) PG8_BAR; }
    PG8_BAR;
    if constexpr (Epi::AFTER_DRAIN) { E.fused(acc, cur, wr, wc, fr, fq, lds, wid, lane); S.done(cur); }
#undef PG8_SA
#undef PG8_SB
#undef PG8_STAGE
#undef PG8_LDA
#undef PG8_LDB
#undef PG8_MMA
#undef PG8_WAIT_V
#undef PG8_WAIT_VN
#undef PG8_WAIT_V8X
#undef PG8_WAIT_L
#undef PG8_BAR
#undef PG8_SCHED
}
}

#ifndef PG8_SP2
#define PG8_SP2 true
#endif
#ifndef PG8_ALIGN
#define PG8_ALIGN true
#endif
#include <hip/hip_bf16.h>
#include <cmath>
namespace attn_body {
using bf16=__hip_bfloat16;
using bf16x8=__attribute__((ext_vector_type(8)))short;
using s16x4=__attribute__((ext_vector_type(4)))short;
using f32x16=__attribute__((ext_vector_type(16)))float;
using u32x4=__attribute__((ext_vector_type(4)))unsigned;
constexpr int SEQ=4096,D=64,PQ=512,PO=1024;
constexpr int NW=8,QBLK=32,QB=QBLK*NW,KVBLK=64,NQB=SEQ/QB;
constexpr int ATTN_UNIT_ROWS=QB;
__device__ __forceinline__ int crow(int r,int hi){return (r&3)+8*(r>>2)+4*hi;}
#define SBAR() __builtin_amdgcn_sched_barrier(0)
__device__ __forceinline__ void cmask(f32x16&p0,f32x16&p1,int jb,int qrel,int hi){
  const float NEG=-INFINITY; const int x=qrel-4*hi-64*jb;
  #pragma unroll
  for(int r=0;r<16;++r){const int c=(r&3)+8*(r>>2); if(c>x)p0[r]=NEG; if(c+32>x)p1[r]=NEG;}
}

constexpr int NSLOT=3, SLOTB=8192;
constexpr int LDS_QB=110592;
constexpr int LDS_K=0, LDS_V=NSLOT*SLOTB;
constexpr float C2=0.125f*1.4426950408889634f;
__device__ __forceinline__ void glds16(const void*gsrc,unsigned lds_dst){unsigned keep;
  asm volatile("s_mov_b32 %0, m0\n\ts_mov_b32 m0, %2\n\ts_nop 0\n\tglobal_load_lds_dwordx4 %1, off\n\ts_mov_b32 m0, %0":"=&s"(keep):"v"(gsrc),"s"(lds_dst):"memory");}
__device__ __forceinline__ void glds16s(const void*sbase,unsigned voff,unsigned lds_dst){unsigned keep;
  const unsigned long long b=(unsigned long long)(uintptr_t)sbase; const unsigned blo=__builtin_amdgcn_readfirstlane((unsigned)b),bhi=__builtin_amdgcn_readfirstlane((unsigned)(b>>32));
  const unsigned long long bu=((unsigned long long)bhi<<32)|blo;
  asm volatile("s_mov_b32 %0, m0\n\ts_mov_b32 m0, %2\n\ts_nop 0\n\tglobal_load_lds_dwordx4 %1, %3\n\ts_mov_b32 m0, %0":"=&s"(keep):"v"(voff),"s"(lds_dst),"s"(bu):"memory");}
__device__ __forceinline__ float max3f(float a,float b,float c){float r;asm("v_max3_f32 %0, %1, %2, %3":"=v"(r):"v"(a),"v"(b),"v"(c));return r;}
__device__ __forceinline__ float max2f(float a,float b){float r;asm("v_max_f32_e32 %0, %1, %2":"=v"(r):"v"(a),"v"(b));return r;}
__device__ __forceinline__ float fadd_s(float a,float b){float r;asm("v_add_f32_e32 %0, %1, %2":"=v"(r):"v"(a),"v"(b));return r;}
__device__ __forceinline__ float fsub_s(float a,float b){float r;asm("v_sub_f32_e32 %0, %1, %2":"=v"(r):"v"(a),"v"(b));return r;}
typedef float f32x2_t __attribute__((ext_vector_type(2))); typedef float f32x4_t __attribute__((ext_vector_type(4))); typedef __bf16 bf16x2_t __attribute__((ext_vector_type(2)));
__device__ __forceinline__ unsigned cvtpk_s(float lo,float hi){f32x2_t v={lo,hi};bf16x2_t b=__builtin_convertvector(v,bf16x2_t);return __builtin_bit_cast(unsigned,b);}
#define WAIT_BAR(N) asm volatile("s_waitcnt vmcnt(" #N ") lgkmcnt(0)\n\ts_barrier":::"memory")

__device__ __forceinline__ void qkt(f32x16&p0,f32x16&p1,const char*Kslot,const bf16x8*qr,const f32x16&negm,int r32,int hi){
  const char*kb=Kslot+hi*1024+r32*16;
  #pragma unroll
  for(int d0=0;d0<4;++d0){
    const bf16x8 b0=*reinterpret_cast<const bf16x8*>(kb+d0*2048);
    const bf16x8 b1=*reinterpret_cast<const bf16x8*>(kb+d0*2048+512);
    if(d0==0){p0=__builtin_amdgcn_mfma_f32_32x32x16_bf16(b0,qr[0],negm,0,0,0);p1=__builtin_amdgcn_mfma_f32_32x32x16_bf16(b1,qr[0],negm,0,0,0);}
    else{p0=__builtin_amdgcn_mfma_f32_32x32x16_bf16(b0,qr[d0],p0,0,0,0);p1=__builtin_amdgcn_mfma_f32_32x32x16_bf16(b1,qr[d0],p1,0,0,0);}}
}
typedef __attribute__((address_space(3))) const char* lds_cptr;
typedef short v4i16_t __attribute__((ext_vector_type(4)));
__device__ __forceinline__ void kload8(bf16x8*kf,lds_cptr kp){
  kf[0]=*(const __attribute__((address_space(3))) bf16x8*)(kp);      kf[1]=*(const __attribute__((address_space(3))) bf16x8*)(kp+512);
  kf[2]=*(const __attribute__((address_space(3))) bf16x8*)(kp+2048); kf[3]=*(const __attribute__((address_space(3))) bf16x8*)(kp+2560);
  kf[4]=*(const __attribute__((address_space(3))) bf16x8*)(kp+4096); kf[5]=*(const __attribute__((address_space(3))) bf16x8*)(kp+4608);
  kf[6]=*(const __attribute__((address_space(3))) bf16x8*)(kp+6144); kf[7]=*(const __attribute__((address_space(3))) bf16x8*)(kp+6656);
}
__device__ __forceinline__ void kload2(bf16x8*kf,lds_cptr kp,int j){ kf[2*j]=*(const __attribute__((address_space(3))) bf16x8*)(kp+j*2048); kf[2*j+1]=*(const __attribute__((address_space(3))) bf16x8*)(kp+j*2048+512); }
__device__ __forceinline__ s16x4 vtr(lds_cptr p){ return __builtin_bit_cast(s16x4,__builtin_amdgcn_ds_read_tr16_b64_v4i16((__attribute__((address_space(3))) v4i16_t*)p)); }
__device__ __forceinline__ float rowmax(const f32x16&p0,const f32x16&p1){
  float a=max3f(p0[0],p0[1],p1[0]),b=max3f(p0[2],p0[3],p1[1]);a=max3f(a,p1[2],p1[3]);
  #pragma unroll
  for(int r=4;r<16;r+=4){a=max3f(a,p0[r],p0[r+1]);b=max3f(b,p0[r+2],p0[r+3]);a=max3f(a,p1[r],p1[r+1]);b=max3f(b,p1[r+2],p1[r+3]);}
  const float m=max2f(a,b);
  auto rr=__builtin_amdgcn_permlane32_swap(__float_as_uint(m),__float_as_uint(m),false,false);
  return max2f(__uint_as_float(rr[0]),__uint_as_float(rr[1]));
}
__device__ __forceinline__ void pv(f32x16*o,int vb,bf16x8 pa0,bf16x8 pa1,bf16x8 pa2,bf16x8 pa3){
  #pragma unroll
  for(int d0=0;d0<2;++d0){s16x4 lo[4],hi[4];
    #pragma unroll
    for(int ks=0;ks<4;++ks){
      asm volatile("ds_read_b64_tr_b16 %0,%1 offset:%c2":"=&v"(lo[ks]):"v"(vb),"i"(d0*4096+ks*1024):"memory");
      asm volatile("ds_read_b64_tr_b16 %0,%1 offset:%c2":"=&v"(hi[ks]):"v"(vb),"i"(d0*4096+ks*1024+512):"memory");}
    asm volatile("s_waitcnt lgkmcnt(0)":::"memory");SBAR();
    #define PK(k) (bf16x8){lo[k][0],lo[k][1],lo[k][2],lo[k][3],hi[k][0],hi[k][1],hi[k][2],hi[k][3]}
    o[d0]=__builtin_amdgcn_mfma_f32_32x32x16_bf16(pa0,PK(0),o[d0],0,0,0);
    o[d0]=__builtin_amdgcn_mfma_f32_32x32x16_bf16(pa1,PK(1),o[d0],0,0,0);
    o[d0]=__builtin_amdgcn_mfma_f32_32x32x16_bf16(pa2,PK(2),o[d0],0,0,0);
    o[d0]=__builtin_amdgcn_mfma_f32_32x32x16_bf16(pa3,PK(3),o[d0],0,0,0);
    #undef PK
  }
}

#ifndef ATTN_STORE16
#define ATTN_STORE16(p,v) asm volatile("global_store_dwordx4 %0, %1, off sc1\n\ts_nop 1"::"v"(p),"v"(v):"memory")
#endif
__device__ __forceinline__ void split3(float x,unsigned&w1,unsigned&w2,unsigned&w3){
  w1=cvtpk_s(x,0.f); const float r1=x-__uint_as_float(w1<<16); w2=cvtpk_s(r1,0.f); const float r2=r1-__uint_as_float(w2<<16); w3=cvtpk_s(r2,0.f); }
struct UnitDesc { const bf16*Q; const bf16*K; const bf16*V; bf16*O; const bf16*G; const float*KM; float a2; float sbc; int qb; int np; int mode; float*O1; const float*SW; float lam; unsigned*qnext; int qslot; const bf16*pfK; const bf16*pfQ; int pfq2; int pre; unsigned*pub; unsigned pubbit; };
template<int THRL,int NVH> __device__ __forceinline__ void attn_unit(const UnitDesc&U,char*shm,const int tid){
  constexpr int LDS_WS=LDS_V+NSLOT*SLOTB*NVH, LDS_OST=LDS_WS+NW*64*4;
  const bf16*Q=U.Q; const bf16*__restrict__ K=U.K; const bf16*__restrict__ V=U.V; bf16*O=U.O; const int qb=U.qb; const float a2=U.a2;
  const int lane=tid&63,r32=lane&31,hi=lane>>5; const int wid=__builtin_amdgcn_readfirstlane(tid>>6);
  const int q0=qb*QB;
  const bf16*Qw=Q+(long)(q0+wid*QBLK)*PQ;
  const bf16*Kh=K,*Vh=V;
  const unsigned lds0=(unsigned)(uintptr_t)shm;
  float*wsf=(float*)(shm+LDS_WS)+wid*64;
  const unsigned koff=(unsigned)((lane*PQ+wid*8)*2);
  const unsigned voff=(unsigned)(((16*(wid&3)+(lane>>2))*PQ+(wid>>2)*32+(lane&3)*8)*2);
  const unsigned kdst=lds0+LDS_K+wid*1024, vdst=lds0+LDS_V+wid*1024;
  #define KT(t) (((t)<4)?(NTF-4+(t)):(NTF-1-(t)))
  #define DMA_K(t,slot) glds16s(Kh+(long)KT(t)*KVBLK*PQ,koff,(unsigned)__builtin_amdgcn_readfirstlane(kdst+(slot)))
  #define DMA_V(t,slot) do{ glds16s(Vh+(long)KT(t)*KVBLK*PQ,voff,(unsigned)__builtin_amdgcn_readfirstlane(vdst+(slot)*NVH)); \
    if constexpr(NVH==2){ glds16s(Vh+(long)KT(t)*KVBLK*PQ+64,voff,(unsigned)__builtin_amdgcn_readfirstlane(vdst+(slot)*NVH+8192)); } }while(0)
  const int vb0=(int)(lds0+LDS_V)+((lane>>4)&1)*32+(lane&3)*8+(4*hi+((lane&15)>>2))*64;
  const char*Kbase=shm+LDS_K; bf16x8 kf[8];
  const lds_cptr shm3=(lds_cptr)shm; const lds_cptr kp0=shm3+LDS_K+hi*1024+r32*16; const lds_cptr vp0=shm3+LDS_V+((lane>>4)&1)*32+(lane&3)*8+(4*hi+((lane&15)>>2))*64;
  const int NTF=(q0+QB)/KVBLK, NT=4+U.np;
#if defined(PROBE_ATT_T) && !defined(PROBE_P0_T)
  unsigned tprev_=(unsigned)__builtin_amdgcn_s_memrealtime();
#endif
  unsigned selmask=0xFFFFu;
#if defined(PROBE_ATT_T) && !defined(PROBE_P0_T)
  { const unsigned tn_=(unsigned)__builtin_amdgcn_s_memrealtime(); if(tid==0){ volatile unsigned*ta_=(volatile unsigned*)(shm+147776+160); ta_[1]+=tn_-tprev_; } tprev_=tn_; }
#endif
  constexpr int LDS_OST2=LDS_V+NSLOT*SLOTB*2+NW*64*4;
  const bool pre=(U.pre!=0);
  if(!pre){DMA_K(0,0);} DMA_V(0,0); if(!pre){DMA_K(1,SLOTB);}
  bf16x8 qr[4];
  const lds_cptr qlp=(lds_cptr)shm+((NVH==2&&U.mode==2)?LDS_OST2:LDS_QB)+wid*4096+lane*16;
  if(!pre){
    #pragma unroll
    for(int d0=0;d0<4;++d0)qr[d0]=*reinterpret_cast<const bf16x8*>(&Qw[(long)r32*PQ+d0*16+hi*8]);
    if constexpr(NVH==2){
      #pragma unroll
      for(int d0=0;d0<4;++d0)*(__attribute__((address_space(3))) bf16x8*)((__attribute__((address_space(3))) char*)qlp+d0*1024)=qr[d0];
    }
  }
  #define QPRE() do{ if(pre){ if constexpr(NVH==1){asm volatile("s_waitcnt vmcnt(1)":::"memory");} else {asm volatile("s_waitcnt vmcnt(2)":::"memory");} \
    _Pragma("unroll") for(int d0=0;d0<4;++d0)qr[d0]=*(const __attribute__((address_space(3))) bf16x8*)(qlp+d0*1024); } }while(0)
  float mhat=0.f,l_reg=0.f;f32x16 o[2*NVH];
  #pragma unroll
  for(int d_=0;d_<2*NVH;++d_)o[d_]=f32x16{};
  const f32x16 negm=f32x16{};
  const int qrel=wid*QBLK+r32;
  #define CMASK(P0,P1,t) do{ if((t)<4)cmask(P0,P1,(t),qrel,hi); }while(0)
  const int qend=q0+QB-1;
  bf16x8 kfa0,kfa1; u32x4 qa={0x3F803F80u,0x3F80u,0u,0u};
  { unsigned a1,a2b,a3,b1,b2,b3; split3(a2*(float)r32,a1,a2b,a3); split3(a2*(float)(r32+32),b1,b2,b3);
    u32x4 k0={a1|(a2b<<16),a3|0x3F800000u,0x3F803F80u,0x3F80u},k1={b1|(b2<<16),b3|0x3F800000u,0x3F803F80u,0x3F80u};
    if(hi){k0=u32x4{0u,0u,0u,0u};k1=k0;}
    kfa0=__builtin_bit_cast(bf16x8,k0);kfa1=__builtin_bit_cast(bf16x8,k1); }
  #define QAUG(t) do{ const int kt_=KT(t); const float u_=a2*(float)(64*kt_-qend)-mhat; unsigned w1_,w2_,w3_; split3(u_,w1_,w2_,w3_); \
    qa.y=0x3F80u|(w1_<<16); qa.z=w2_|(w3_<<16); qa.w=((t)>=4 && (((selmask>>(kt_>>2))&1u)==0u))?0xF14Au:0u; }while(0)
  #define QAF __builtin_bit_cast(bf16x8,qa)
  bool resc=false;
  #define START(P0,P1) do{ const float rm=rowmax(P0,P1); resc=false; \
    { const float dl=rm; mhat=fadd_s(mhat,dl); \
      _Pragma("unroll") for(int r=0;r<16;++r){P0[r]=fsub_s(P0[r],dl);P1[r]=fsub_s(P1[r],dl);} \
      } \
    _Pragma("unroll") for(int r=0;r<16;++r)P0[r]=__builtin_amdgcn_exp2f(P0[r]); }while(0)
  #define RESC() do{ if(resc){ asm volatile("s_waitcnt lgkmcnt(0)":::"memory"); \
      _Pragma("unroll") for(int d_=0;d_<2*NVH;++d_) _Pragma("unroll") for(int r=0;r<16;++r)o[d_][r]*=wsf[crow(r,hi)]; } }while(0)
  f32x16 pA0,pA1,pB0,pB1;
  int sl_prev=0,sl_cur=0,sl_next=SLOTB;
  #define ROT() do{sl_prev=sl_cur;sl_cur=sl_next;sl_next=(sl_next==(NSLOT-1)*SLOTB)?0:sl_next+SLOTB;}while(0)
  if(!pre){DMA_K(2,2*SLOTB);}
  if(U.KM!=nullptr && qb>3){
    char*img=shm+LDS_OST;
    int lane_g=lane; asm volatile("":"+v"(lane_g));
    for(int i=wid*64+lane_g;i<1024;i+=NW*64){ const int j=i>>6,d=i&63; const float s=(j<qb)?(U.KM[(j*2)*64+d]+U.KM[(j*2+1)*64+d]):0.f;
      const unsigned hp=cvtpk_s(s,0.f); const unsigned lp=cvtpk_s(s-__uint_as_float(hp<<16),0.f); const int off=(d>>3)*512+j*16+(d&7)*2;
      *reinterpret_cast<unsigned short*>(img+off)=(unsigned short)hp; *reinterpret_cast<unsigned short*>(img+4096+off)=(unsigned short)lp; }
    __syncthreads();
    QPRE();
    const int r32g=lane_g&31,hig=lane_g>>5;
    f32x16 gacc=f32x16{};
    #pragma unroll
    for(int d0=0;d0<4;++d0){ const bf16x8 ah=*reinterpret_cast<const bf16x8*>(img+(2*d0+hig)*512+r32g*16), al=*reinterpret_cast<const bf16x8*>(img+4096+(2*d0+hig)*512+r32g*16);
      gacc=__builtin_amdgcn_mfma_f32_32x32x16_bf16(ah,qr[d0],gacc,0,0,0); gacc=__builtin_amdgcn_mfma_f32_32x32x16_bf16(al,qr[d0],gacc,0,0,0); }
    const float KLOW=-3.0e38f;
    float ta=-3.2e38f,tb=-3.2e38f,tc=-3.2e38f;
    #define TOP3_INS(x) do{ const float x_=(x); const float u_=__builtin_fminf(__builtin_fminf(ta,tb),x_); const float b_=__builtin_amdgcn_fmed3f(ta,tb,x_); ta=__builtin_fmaxf(ta,x_); tb=b_; tc=__builtin_fmaxf(tc,u_); }while(0)
    #define TOP3_KEY(g,j) __uint_as_float((__float_as_uint(g)&0xFFFFFFF0u)|(unsigned)(15-(j)))
    #pragma unroll
    for(int r=0;r<8;++r){ const int bl=(r&3)+8*(r>>2); float g=gacc[r]; if(bl+4*hig>=qb)g=KLOW;
      auto rr=__builtin_amdgcn_permlane32_swap(__float_as_uint(g),__float_as_uint(g),false,false);
      TOP3_INS(TOP3_KEY(__uint_as_float(rr[0]),bl)); TOP3_INS(TOP3_KEY(__uint_as_float(rr[1]),bl+4)); }
    unsigned m=0u;
    if(ta>-1.0e38f)m|=1u<<(15u-(__float_as_uint(ta)&15u));
    if(tb>-1.0e38f)m|=1u<<(15u-(__float_as_uint(tb)&15u));
    if(tc>-1.0e38f)m|=1u<<(15u-(__float_as_uint(tc)&15u));
    #undef TOP3_INS
    #undef TOP3_KEY
    selmask=m;
  } else { QPRE(); }
  #undef QPRE
  #define WAIT_BAR_N(n) do{ if constexpr((n)==0){WAIT_BAR(0);} else if constexpr((n)==1){WAIT_BAR(1);} else if constexpr((n)==2){WAIT_BAR(2);} else if constexpr((n)==3){WAIT_BAR(3);} else {static_assert((n)<=4,"");WAIT_BAR(4);} }while(0)
  if(pre){WAIT_BAR_N(NVH);} else {WAIT_BAR_N(2+NVH);}

#if defined(PROBE_ATT_T) && !defined(PROBE_P0_T)
  { const unsigned tn_=(unsigned)__builtin_amdgcn_s_memrealtime(); if(tid==0){ volatile unsigned*ta_=(volatile unsigned*)(shm+147776+160); ta_[5]+=tn_-tprev_; } tprev_=tn_; }
#endif
  QAUG(0); qkt(pA0,pA1,Kbase,qr,negm,r32,hi);pA0=__builtin_amdgcn_mfma_f32_32x32x16_bf16(kfa0,QAF,pA0,0,0,0);pA1=__builtin_amdgcn_mfma_f32_32x32x16_bf16(kfa1,QAF,pA1,0,0,0);asm volatile("s_nop 15\n\ts_nop 7":"+v"(pA0),"+v"(pA1));CMASK(pA0,pA1,0);
  START(pA0,pA1);
  QAUG(1);
  _Pragma("unroll") for(int r=0;r<16;++r)pA1[r]=__builtin_amdgcn_exp2f(pA1[r]);

#if defined(PROBE_ATT_T) && !defined(PROBE_P0_T)
  { const unsigned tn_=(unsigned)__builtin_amdgcn_s_memrealtime(); if(tid==0){ volatile unsigned*ta_=(volatile unsigned*)(shm+147776+160); ta_[6]+=tn_-tprev_; } tprev_=tn_; }
#endif
  WAIT_BAR(0);

#if defined(PROBE_ATT_T) && !defined(PROBE_P0_T)
  { const unsigned tn_=(unsigned)__builtin_amdgcn_s_memrealtime(); if(tid==0){ volatile unsigned*ta_=(volatile unsigned*)(shm+147776+160); ta_[7]+=tn_-tprev_; } tprev_=tn_; }
#endif
  DMA_K(3,0);DMA_V(1,SLOTB);
  ROT();
  kload8(kf,kp0+sl_cur);
  WAIT_BAR_N(1+NVH);
  s16x4 vlo[8],vhi[8]; u32x4 pw0,pw1,pw2,pw3;
  #define PKW(P,B) cvtpk_s(P[B],P[B+1])
  #define PAF(k) __builtin_bit_cast(bf16x8,pw##k)
  #define VFR(i) (bf16x8){vlo[i][0],vlo[i][1],vlo[i][2],vlo[i][3],vhi[i][0],vhi[i][1],vhi[i][2],vhi[i][3]}
  #define PIN(x) asm volatile("":"+v"(x))
  #define MX3(a,b,c) __builtin_fmaxf(__builtin_fmaxf((a),(b)),(c))
  #define GAPA(MF,A0,A1,A2,A3,W0,W1,PW) do{ MF; sacc+=A0; sacc+=A1; sacc+=A2; sacc+=A3; PIN(sacc); W0; W1; PIN(PW); SBAR(); }while(0)
  #define EX(v) __builtin_amdgcn_exp2f(v)
  #define GAPB(MF,X,B) do{ MF; X[B]=EX(X[B]); X[B+1]=EX(X[B+1]); X[B+2]=EX(X[B+2]); X[B+3]=EX(X[B+3]); PIN(X); SBAR(); }while(0)
  #define GAPB2(MF,X,B,RL) do{ MF; X[B]=EX(X[B]); X[B+1]=EX(X[B+1]); RL; PIN(X); SBAR(); }while(0)
  #define VRDB(i) do{ vlo[i]=vtr(vp_+(8192+((i)>>2)*4096+((i)&3)*1024)); vhi[i]=vtr(vp_+(8192+((i)>>2)*4096+((i)&3)*1024+512)); }while(0)
  #define VRD(i) do{ vlo[i]=vtr(vp_+(((i)>>2)*4096+((i)&3)*1024)); vhi[i]=vtr(vp_+(((i)>>2)*4096+((i)&3)*1024+512)); }while(0)
  #define KRD(G,j) do{ if(G){ kload2(kf,kp0+sl_next,j); SBAR(); } }while(0)
  bf16x8 qx_=qr[0],qy_=qr[1];
  #define QX  (NVH==2?qx_:qr[0])
  #define QY  (NVH==2?qy_:qr[1])
  #define QX2 (NVH==2?qx_:qr[2])
  #define QY3 (NVH==2?qy_:qr[3])
  #define QLD(dst,d0) do{ if constexpr(NVH==2){ dst=*(const __attribute__((address_space(3))) bf16x8*)(qlp+(d0)*1024); } }while(0)
  #define STEP(C0,C1,P0,P1,t,GK,GV,GL) do{ SBAR(); \
    const lds_cptr vp_=vp0+sl_prev*NVH; \
    VRD(0); SBAR(); float sacc=(P0[0]+P0[1]); \
    GAPA(C0=__builtin_amdgcn_mfma_f32_32x32x16_bf16(kf[0],QX,negm,0,0,0), P0[2],P0[3],P0[4],P0[5],     pw0[0]=PKW(P0,0), pw0[1]=PKW(P0,2), pw0); QLD(qy_,1); \
    VRD(4); SBAR(); GAPA(C1=__builtin_amdgcn_mfma_f32_32x32x16_bf16(kf[1],QX,negm,0,0,0), P0[6],P0[7],P0[8],P0[9],     pw0[2]=PKW(P0,4), pw0[3]=PKW(P0,6), pw0); \
    VRD(1); SBAR(); GAPA(C0=__builtin_amdgcn_mfma_f32_32x32x16_bf16(kf[2],QY,C0,0,0,0),   P0[10],P0[11],P0[12],P0[13], pw1[0]=PKW(P0,8), pw1[1]=PKW(P0,10), pw1); QLD(qx_,2); \
    VRD(5); SBAR(); GAPA(C1=__builtin_amdgcn_mfma_f32_32x32x16_bf16(kf[3],QY,C1,0,0,0),   P0[14],P0[15],P1[0],P1[1],   pw1[2]=PKW(P0,12),pw1[3]=PKW(P0,14), pw1); \
    VRD(2); SBAR(); GAPA(C0=__builtin_amdgcn_mfma_f32_32x32x16_bf16(kf[4],QX2,C0,0,0,0),   P1[2],P1[3],P1[4],P1[5],     pw2[0]=PKW(P1,0), pw2[1]=PKW(P1,2), pw2); QLD(qy_,3); \
    VRD(6); SBAR(); GAPA(C1=__builtin_amdgcn_mfma_f32_32x32x16_bf16(kf[5],QX2,C1,0,0,0),   P1[6],P1[7],P1[8],P1[9],     pw2[2]=PKW(P1,4), pw2[3]=PKW(P1,6), pw2); \
    VRD(3); SBAR(); GAPA(C0=__builtin_amdgcn_mfma_f32_32x32x16_bf16(kf[6],QY3,C0,0,0,0),   P1[10],P1[11],P1[12],P1[13], pw3[0]=PKW(P1,8), pw3[1]=PKW(P1,10), pw3); QLD(qx_,0); \
    VRD(7); SBAR(); GAPA(C1=__builtin_amdgcn_mfma_f32_32x32x16_bf16(kf[7],QY3,C1,0,0,0),   P1[14],P1[15],0.f,0.f,       pw3[2]=PKW(P1,12),pw3[3]=PKW(P1,14), pw3); \
    C0=__builtin_amdgcn_mfma_f32_32x32x16_bf16(kfa0,QAF,C0,0,0,0); C1=__builtin_amdgcn_mfma_f32_32x32x16_bf16(kfa1,QAF,C1,0,0,0); \
    l_reg+=sacc; \
    if(GK){DMA_K((t)+3,sl_cur);} if(GV){DMA_V((t)+1,sl_next);} \
    CMASK(C0,C1,t); \
    resc=false; \
      \
      \
    if(__builtin_expect(__any(a2*(float)(64*KT(t)-qend)-mhat+U.sbc>(float)THRL-0.0625f),0)) \
    { float a=MX3(C0[0],C0[1],C1[0]),b=MX3(C0[2],C0[3],C1[1]); a=MX3(a,C1[2],C1[3]); \
      _Pragma("unroll") for(int r=4;r<16;r+=4){a=MX3(a,C0[r],C0[r+1]);b=MX3(b,C0[r+2],C0[r+3]);a=MX3(a,C1[r],C1[r+1]);b=MX3(b,C1[r+2],C1[r+3]);} \
      float rm=__builtin_fmaxf(a,b); { auto rr=__builtin_amdgcn_permlane32_swap(__float_as_uint(rm),__float_as_uint(rm),false,false); rm=__builtin_fmaxf(__uint_as_float(rr[0]),__uint_as_float(rr[1])); } \
      if(__builtin_expect(__any(rm>(float)THRL),0)){ const float dl=__builtin_fmaxf(rm,0.f); mhat+=dl; \
        _Pragma("unroll") for(int r=0;r<16;++r){C0[r]-=dl;C1[r]-=dl;} \
        const float f=__builtin_amdgcn_exp2f(-dl); l_reg*=f; if(hi==0)wsf[r32]=f; resc=true; } } \
    QAUG((t)+1);   \
    SBAR(); \
    if constexpr(NVH==1){ \
      GAPB(o[0]=__builtin_amdgcn_mfma_f32_32x32x16_bf16(PAF(0),VFR(0),o[0],0,0,0), C0,0); \
      GAPB(o[1]=__builtin_amdgcn_mfma_f32_32x32x16_bf16(PAF(0),VFR(4),o[1],0,0,0), C0,4); \
      KRD(GL,0); GAPB(o[0]=__builtin_amdgcn_mfma_f32_32x32x16_bf16(PAF(1),VFR(1),o[0],0,0,0), C0,8); \
      KRD(GL,1); GAPB(o[1]=__builtin_amdgcn_mfma_f32_32x32x16_bf16(PAF(1),VFR(5),o[1],0,0,0), C0,12); \
      KRD(GL,2); GAPB(o[0]=__builtin_amdgcn_mfma_f32_32x32x16_bf16(PAF(2),VFR(2),o[0],0,0,0), C1,0); \
      KRD(GL,3); GAPB(o[1]=__builtin_amdgcn_mfma_f32_32x32x16_bf16(PAF(2),VFR(6),o[1],0,0,0), C1,4); \
      GAPB(o[0]=__builtin_amdgcn_mfma_f32_32x32x16_bf16(PAF(3),VFR(3),o[0],0,0,0), C1,8); \
      GAPB(o[1]=__builtin_amdgcn_mfma_f32_32x32x16_bf16(PAF(3),VFR(7),o[1],0,0,0), C1,12); \
    } else { \
      GAPB2(o[0]=__builtin_amdgcn_mfma_f32_32x32x16_bf16(PAF(0),VFR(0),o[0],0,0,0), C0,0, VRDB(0)); \
      GAPB2(o[1]=__builtin_amdgcn_mfma_f32_32x32x16_bf16(PAF(0),VFR(4),o[1],0,0,0), C0,2, VRDB(4)); \
      KRD(GL,0); GAPB2(o[0]=__builtin_amdgcn_mfma_f32_32x32x16_bf16(PAF(1),VFR(1),o[0],0,0,0), C0,4, VRDB(1)); \
      KRD(GL,1); GAPB2(o[1]=__builtin_amdgcn_mfma_f32_32x32x16_bf16(PAF(1),VFR(5),o[1],0,0,0), C0,6, VRDB(5)); \
      KRD(GL,2); GAPB2(o[0]=__builtin_amdgcn_mfma_f32_32x32x16_bf16(PAF(2),VFR(2),o[0],0,0,0), C0,8, VRDB(2)); \
      KRD(GL,3); GAPB2(o[1]=__builtin_amdgcn_mfma_f32_32x32x16_bf16(PAF(2),VFR(6),o[1],0,0,0), C0,10, VRDB(6)); \
      GAPB2(o[0]=__builtin_amdgcn_mfma_f32_32x32x16_bf16(PAF(3),VFR(3),o[0],0,0,0), C0,12, VRDB(3)); \
      GAPB2(o[1]=__builtin_amdgcn_mfma_f32_32x32x16_bf16(PAF(3),VFR(7),o[1],0,0,0), C0,14, VRDB(7)); \
      GAPB2(o[2]=__builtin_amdgcn_mfma_f32_32x32x16_bf16(PAF(0),VFR(0),o[2],0,0,0), C1,0, (void)0); \
      GAPB2(o[3]=__builtin_amdgcn_mfma_f32_32x32x16_bf16(PAF(0),VFR(4),o[3],0,0,0), C1,2, (void)0); \
      GAPB2(o[2]=__builtin_amdgcn_mfma_f32_32x32x16_bf16(PAF(1),VFR(1),o[2],0,0,0), C1,4, (void)0); \
      GAPB2(o[3]=__builtin_amdgcn_mfma_f32_32x32x16_bf16(PAF(1),VFR(5),o[3],0,0,0), C1,6, (void)0); \
      GAPB2(o[2]=__builtin_amdgcn_mfma_f32_32x32x16_bf16(PAF(2),VFR(2),o[2],0,0,0), C1,8, (void)0); \
      GAPB2(o[3]=__builtin_amdgcn_mfma_f32_32x32x16_bf16(PAF(2),VFR(6),o[3],0,0,0), C1,10, (void)0); \
      GAPB2(o[2]=__builtin_amdgcn_mfma_f32_32x32x16_bf16(PAF(3),VFR(3),o[2],0,0,0), C1,12, (void)0); \
      GAPB2(o[3]=__builtin_amdgcn_mfma_f32_32x32x16_bf16(PAF(3),VFR(7),o[3],0,0,0), C1,14, (void)0); \
    } \
    }while(0)
  #define ENDW(tt) do{ if((tt)+3<NT){WAIT_BAR_N(1+NVH);} else if((tt)+2<NT){WAIT_BAR_N(NVH);} else {WAIT_BAR(0);} }while(0)

#if defined(PROBE_ATT_T) && !defined(PROBE_P0_T)
  { const unsigned tn_=(unsigned)__builtin_amdgcn_s_memrealtime(); if(tid==0){ volatile unsigned*ta_=(volatile unsigned*)(shm+147776+160); ta_[2]+=tn_-tprev_; } tprev_=tn_; }
#endif
  if(wid>=4)__builtin_amdgcn_s_setprio(1);
  int t=1;
  for(;t+1<NT;t+=2){
    STEP(pB0,pB1,pA0,pA1,t,(t+3<NT),(t+1<NT),(t+1<NT));       ENDW(t);
    if(t==1 && U.pub!=nullptr && tid==0){ (void)__hip_atomic_fetch_add(U.pub,U.pubbit,__ATOMIC_RELAXED,__HIP_MEMORY_SCOPE_AGENT); }
    RESC(); ROT();
    STEP(pA0,pA1,pB0,pB1,t+1,(t+4<NT),(t+2<NT),(t+2<NT));     ENDW(t+1); RESC(); ROT();
  }
  if(U.pfK!=nullptr){
    glds16s(U.pfK,koff,(unsigned)__builtin_amdgcn_readfirstlane(kdst)); glds16s(U.pfK+(long)KVBLK*PQ,koff,(unsigned)__builtin_amdgcn_readfirstlane(kdst+SLOTB)); glds16s(U.pfK+(long)2*KVBLK*PQ,koff,(unsigned)__builtin_amdgcn_readfirstlane(kdst+2*SLOTB));
    int lane_p=lane; asm volatile("":"+v"(lane_p));
    const unsigned qoff=(unsigned)((((lane_p&31))*PQ+(lane_p>>5)*8)*2);
    const unsigned qdst=lds0+(U.pfq2?LDS_OST2:LDS_QB)+wid*4096;
    const bf16*qsrc=U.pfQ+(long)(wid*QBLK)*PQ;
    #pragma unroll
    for(int d0=0;d0<4;++d0)glds16s(qsrc+d0*16,qoff,(unsigned)__builtin_amdgcn_readfirstlane(qdst+d0*1024));
  }
  if(U.G!=nullptr && U.mode!=1){
    int lane_q=lane; asm volatile("":"+v"(lane_q));
    const unsigned goff=(unsigned)(((lane_q>>3)*PQ+(lane_q&7)*8)*2);
    const bf16*gsrc=U.G+(long)(q0+wid*QBLK)*PQ;
    const unsigned gdst=lds0+LDS_QB+wid*4096;
    #pragma unroll
    for(int i=0;i<4;++i)glds16s(gsrc+(long)(i*8)*PQ,goff,(unsigned)__builtin_amdgcn_readfirstlane(gdst+i*1024));
    if constexpr(NVH==2){
      #pragma unroll
      for(int i=0;i<2;++i)glds16s(gsrc+64+(long)(i*8)*PQ,goff,(unsigned)__builtin_amdgcn_readfirstlane(lds0+LDS_K+wid*2048+i*1024));
      #pragma unroll
      for(int i=2;i<4;++i)glds16s(gsrc+64+(long)(i*8)*PQ,goff,(unsigned)__builtin_amdgcn_readfirstlane(lds0+LDS_V+sl_next*NVH+wid*2048+(i-2)*1024));
    }
  }
  const int sl_free=sl_next;
  STEP(pB0,pB1,pA0,pA1,NT-1,false,false,false); RESC();
  __builtin_amdgcn_s_setprio(0);
  unsigned tk_=0u;
  if(U.qnext!=nullptr && tid==0){ long zo_=0; asm volatile("":"+v"(zo_)); tk_=__hip_atomic_fetch_add(U.qnext+zo_,1u,__ATOMIC_RELAXED,__HIP_MEMORY_SCOPE_AGENT); }
  { float sacc=pB0[0]+pB0[1]; _Pragma("unroll") for(int r=2;r<16;++r)sacc+=pB0[r]; _Pragma("unroll") for(int r=0;r<16;++r)sacc+=pB1[r]; l_reg+=sacc;
    pw0=(u32x4){PKW(pB0,0),PKW(pB0,2),PKW(pB0,4),PKW(pB0,6)};pw1=(u32x4){PKW(pB0,8),PKW(pB0,10),PKW(pB0,12),PKW(pB0,14)};pw2=(u32x4){PKW(pB1,0),PKW(pB1,2),PKW(pB1,4),PKW(pB1,6)};pw3=(u32x4){PKW(pB1,8),PKW(pB1,10),PKW(pB1,12),PKW(pB1,14)};
    SBAR(); pv(o,vb0+sl_cur*NVH,PAF(0),PAF(1),PAF(2),PAF(3)); if constexpr(NVH==2){ pv(o+2,vb0+sl_cur*NVH+8192,PAF(0),PAF(1),PAF(2),PAF(3)); } }
  #undef PKW
  #undef PAF
  #undef VFR
  #undef PIN
  #undef MX3
  #undef GAPA
  #undef GAPB
  #undef GAPB2
  #undef VRDB
  #undef EX
  #undef VRD
  #undef KRD
  #undef STEP
  #undef QX
  #undef QY
  #undef QX2
  #undef QY3
  #undef QLD
  #undef ENDW

#if defined(PROBE_ATT_T) && !defined(PROBE_P0_T)
  { const unsigned tn_=(unsigned)__builtin_amdgcn_s_memrealtime(); if(tid==0){ volatile unsigned*ta_=(volatile unsigned*)(shm+147776+160); ta_[3]+=tn_-tprev_; } tprev_=tn_; }
#endif
  int lane_e=lane; asm volatile("":"+v"(lane_e));
  const int hi_e=lane_e>>5,r32_e=lane_e&31;
  bf16*Ow=O+(long)(q0+wid*QBLK)*PO; const bf16*Gw=(U.G!=nullptr && U.mode!=1)?U.G+(long)(q0+wid*QBLK)*PQ:nullptr;
  const lds_cptr glp=shm3+LDS_QB+wid*4096+lane_e*16;
  f32x4_t swv[NVH==2?2:1][2];
  if constexpr(NVH==2){ if(U.mode==2){
    #pragma unroll
    for(int p=0;p<2;++p){ swv[p][0]=*reinterpret_cast<const f32x4_t*>(U.SW+p*64+(lane_e&7)*8); swv[p][1]=*reinterpret_cast<const f32x4_t*>(U.SW+p*64+(lane_e&7)*8+4); } } }
  f32x4_t o1v[NVH==2?2:1][4];
  float*o1=nullptr;
  if constexpr(NVH==2){ o1=U.O1+(long)wid*4096+lane_e*4;
    if(U.mode==2){
      #pragma unroll
      for(int d0=0;d0<2;++d0)
        #pragma unroll
        for(int r4=0;r4<4;++r4)o1v[d0][r4]=*reinterpret_cast<const f32x4_t*>(o1+(d0*4+r4)*256);
    } }
  {auto rr=__builtin_amdgcn_permlane32_swap(__float_as_uint(l_reg),__float_as_uint(l_reg),false,false);l_reg=__uint_as_float(rr[0])+__uint_as_float(rr[1]);}
  if(hi==0)wsf[32+r32]=l_reg;asm volatile("s_waitcnt lgkmcnt(0)":::"memory");
  float rli[16];
  #pragma unroll
  for(int r=0;r<16;++r)rli[r]=__builtin_amdgcn_rcpf(wsf[32+crow(r,0)+4*hi_e]);
  float rs[16];
  #pragma unroll
  for(int r=0;r<16;++r)rs[r]=rli[r];
  bool store_rows=true;
  if constexpr(NVH==2){
    if(U.mode==1){
      #pragma unroll
      for(int d0=0;d0<4;++d0)
        #pragma unroll
        for(int r4=0;r4<4;++r4){ f32x4_t v={o[d0][4*r4]*rli[4*r4],o[d0][4*r4+1]*rli[4*r4+1],o[d0][4*r4+2]*rli[4*r4+2],o[d0][4*r4+3]*rli[4*r4+3]}; *reinterpret_cast<f32x4_t*>(o1+(d0*4+r4)*256)=v; }
      store_rows=false;
    } else if(U.mode==2){
      float ss[16];
      #pragma unroll
      for(int r=0;r<16;++r)ss[r]=0.f;
      #pragma unroll
      for(int d0=0;d0<4;++d0)
        #pragma unroll
        for(int r4=0;r4<4;++r4){ f32x4_t v; if(d0<2)v=o1v[d0][r4]; else v=*reinterpret_cast<const f32x4_t*>(o1+(d0*4+r4)*256);
          #pragma unroll
          for(int j=0;j<4;++j){ const int r=4*r4+j; const float d=v[j]-U.lam*(o[d0][r]*rli[r]); o[d0][r]=d; ss[r]=__builtin_fmaf(d,d,ss[r]); } }
      #pragma unroll
      for(int r=0;r<16;++r){ float s=ss[r]; s+=__shfl_xor(s,1); s+=__shfl_xor(s,2); s+=__shfl_xor(s,4); s+=__shfl_xor(s,8); s+=__shfl_xor(s,16); rs[r]=__builtin_amdgcn_rsqf(s*(1.0f/128.0f)+1e-6f); }
    }
  }
  if(Gw){ if(wid==0 && U.qnext!=nullptr){asm volatile("s_waitcnt vmcnt(1)":::"memory");} else {asm volatile("s_waitcnt vmcnt(0)":::"memory");} }
  if(store_rows){ bf16*stg=(bf16*)(shm+LDS_OST)+wid*2048;
    bf16*stw=stg+hi_e*256+r32_e;
    #pragma unroll
    for(int p=0;p<NVH;++p){
    #pragma unroll
    for(int r=0;r<16;++r){const int orow=crow(r,0);
      #pragma unroll
      for(int d0=0;d0<2;++d0)stw[orow*64+d0*32]=__float2bfloat16(o[2*p+d0][r]*rs[r]);}
    asm volatile("s_waitcnt lgkmcnt(0)":::"memory");
    #pragma unroll
    for(int i=0;i<4;++i){const int row=i*8+(lane_e>>3),ch=lane_e&7; u32x4 v=*(const u32x4*)(stg+row*64+ch*8);
      if(Gw){ u32x4 gg; if(NVH==1||p==0)gg=*(const __attribute__((address_space(3))) u32x4*)(glp+i*1024);
        else gg=*(const __attribute__((address_space(3))) u32x4*)(shm3+((i<2)?(LDS_K+wid*2048+i*1024):(LDS_V+sl_free*NVH+wid*2048+(i-2)*1024))+lane_e*16);
        if(NVH==2 && U.mode==2){ const f32x4_t w0=swv[NVH==2?p:0][0],w1=swv[NVH==2?p:0][1];
          #define MUL3(a,b,wl,wh) cvtpk_s(__uint_as_float((a)<<16)*__uint_as_float((b)<<16)*(wl),__uint_as_float((a)&0xffff0000u)*__uint_as_float((b)&0xffff0000u)*(wh))
          v.x=MUL3(v.x,gg.x,w0[0],w0[1]);v.y=MUL3(v.y,gg.y,w0[2],w0[3]);v.z=MUL3(v.z,gg.z,w1[0],w1[1]);v.w=MUL3(v.w,gg.w,w1[2],w1[3]);
          #undef MUL3
        } else {
        #define MULPK(a,b) cvtpk_s(__uint_as_float((a)<<16)*__uint_as_float((b)<<16),__uint_as_float((a)&0xffff0000u)*__uint_as_float((b)&0xffff0000u))
        v.x=MULPK(v.x,gg.x);v.y=MULPK(v.y,gg.y);v.z=MULPK(v.z,gg.z);v.w=MULPK(v.w,gg.w);
        #undef MULPK
        }
      }
      ATTN_STORE16(Ow+(long)row*PO+p*64+ch*8,v);}
    asm volatile("s_waitcnt lgkmcnt(0)":::"memory");
    } }
  if(U.qnext!=nullptr && tid==0)*(__attribute__((address_space(3))) unsigned*)((__attribute__((address_space(3))) char*)shm3+U.qslot)=tk_;
  asm volatile("s_waitcnt lgkmcnt(0)\n\ts_barrier":::"memory");

#if defined(PROBE_ATT_T) && !defined(PROBE_P0_T)
  { const unsigned tn_=(unsigned)__builtin_amdgcn_s_memrealtime(); if(tid==0){ volatile unsigned*ta_=(volatile unsigned*)(shm+147776+160); ta_[4]+=tn_-tprev_; } tprev_=tn_; }
#endif
  #undef DMA_K
  #undef DMA_V
  #undef KT
  #undef QAUG
  #undef QAF
  #undef CMASK
  #undef START
  #undef RESC
  #undef ROT
}
constexpr int ATTN_LDS_BYTES=LDS_V+NSLOT*SLOTB*2+NW*64*4+NW*4096;
#undef SBAR
#undef WAIT_BAR
}
#define GAS __attribute__((address_space(1)))
#define LAS __attribute__((address_space(3)))
typedef unsigned short bf16;
typedef unsigned v4u __attribute__((ext_vector_type(4)));
typedef float f32x4 __attribute__((ext_vector_type(4)));
typedef short bf16x8 __attribute__((ext_vector_type(8)));
typedef GAS unsigned gu32;
typedef GAS unsigned long long gu64;
#define RLX_AGENT __ATOMIC_RELAXED, __HIP_MEMORY_SCOPE_AGENT
#define LDS_WAIT() asm volatile("s_waitcnt lgkmcnt(0)" ::: "memory")
#define VM_WAIT() asm volatile("s_waitcnt vmcnt(0)" ::: "memory")
__device__ __forceinline__ unsigned long long rt() { return __builtin_amdgcn_s_memrealtime(); }
__device__ __forceinline__ unsigned f2bf(float f) { unsigned u = __builtin_bit_cast(unsigned, f); return (u + 0x7fffu + ((u >> 16) & 1u)) >> 16; }
__device__ __forceinline__ unsigned pk2(float lo, float hi) { return f2bf(lo) | (f2bf(hi) << 16); }

#define XB_TMO      128
#define XB_XCNT(j)  (256  + 64 * (j))
#define XB_XSUB(j)  (1280 + 64 * (j))
#define XB_XGEN(j)  (2304 + 64 * (j))
#define XB_TOP      3328
#define XB_TOPGEN   3392
#define XCD_BAR_WORDS 3456
#define XB_SPIN_CAP (1u << 18)

__device__ __forceinline__ unsigned xb_ld(unsigned* p)              { return __hip_atomic_load(p, __ATOMIC_RELAXED, __HIP_MEMORY_SCOPE_AGENT); }
__device__ __forceinline__ unsigned xb_add(unsigned* p, unsigned v) { return __hip_atomic_fetch_add(p, v, __ATOMIC_RELAXED, __HIP_MEMORY_SCOPE_AGENT); }
__device__ __forceinline__ unsigned xb_xcc_id() { return (unsigned)__builtin_amdgcn_s_getreg((3 << 11) | 20) & 0xFu; }
#define XB_SPIN(cond, bar) do { unsigned _sp = 0; while (cond) { __builtin_amdgcn_s_sleep(1); \
    if ((++_sp & 255u) == 0u) { if (xb_ld(&(bar)[XB_TMO])) break; if (_sp > XB_SPIN_CAP) { atomicAdd(&(bar)[XB_TMO], 1u); break; } } } } while (0)

struct XcdBarrier {
    unsigned* bar; unsigned x;
    volatile LAS unsigned* st;
};

__device__ __forceinline__ XcdBarrier xcd_barrier_post(unsigned* bar, volatile LAS unsigned* st, const int tid) {
    XcdBarrier b; b.bar = bar; b.x = xb_xcc_id(); b.st = st;
    if (tid == 0) (void)xb_add(&bar[XB_XCNT(b.x)], 1u);
    return b;
}

__device__ __forceinline__ void xcd_barrier(const XcdBarrier& b, const int tid) {
    asm volatile("s_waitcnt vmcnt(0)" ::: "memory");
    __syncthreads();
    if (tid < 64 && b.st[0] == 0u) {
        unsigned* bar = b.bar;
        const unsigned G = gridDim.x * gridDim.y * gridDim.z;
        unsigned cnt = 1u, mine = 1u, sp = 0u;
        for (;;) {
            const unsigned c = (tid < 16) ? xb_ld(&bar[XB_XCNT(tid)]) : 0u;
            unsigned sum = c; sum += __shfl_xor(sum, 1); sum += __shfl_xor(sum, 2); sum += __shfl_xor(sum, 4); sum += __shfl_xor(sum, 8);
            sum = (unsigned)__builtin_amdgcn_readfirstlane((int)sum);
            cnt = (unsigned)__popcll(__ballot(c > 0u)); mine = (unsigned)__builtin_amdgcn_readlane((int)c, (int)b.x);
            if (sum == G) break;
            __builtin_amdgcn_s_sleep(1);
            if ((++sp & 255u) == 0u) { if (__builtin_amdgcn_readfirstlane((int)xb_ld(&bar[XB_TMO]))) break; if (sp > XB_SPIN_CAP) { if (tid == 0) atomicAdd(&bar[XB_TMO], 1u); break; } }
        }
        if (tid == 0) { b.st[0] = mine > 0u ? mine : 1u; b.st[1] = cnt > 0u ? cnt : 1u; }
    }
    if (tid == 0) {
        unsigned* bar = b.bar;
        __builtin_amdgcn_s_waitcnt(0);
        const unsigned nloc = b.st[0], nx = b.st[1];
        const unsigned old = xb_add(&bar[XB_XSUB(b.x)], 1u);
        const unsigned gen = old / nloc;
        if (old + 1u == (gen + 1u) * nloc) {
            __builtin_amdgcn_fence(__ATOMIC_RELEASE, "agent");
            asm volatile("s_waitcnt vmcnt(0)" ::: "memory");
            const unsigned og = xb_add(&bar[XB_TOP], 1u);
            const unsigned tg = og / nx;
            if (og + 1u == (tg + 1u) * nx) xb_add(&bar[XB_TOPGEN], 1u);
            else XB_SPIN(xb_ld(&bar[XB_TOPGEN]) == tg, bar);
            __builtin_amdgcn_fence(__ATOMIC_ACQUIRE, "agent");
            xb_add(&bar[XB_XGEN(b.x)], 1u);
            asm volatile("s_waitcnt vmcnt(0)" ::: "memory");
        } else {
            XB_SPIN(xb_ld(&bar[XB_XGEN(b.x)]) == gen, bar);
            __builtin_amdgcn_fence(__ATOMIC_ACQUIRE, "agent");
            asm volatile("s_waitcnt vmcnt(0)" ::: "memory");
        }
    }
    __syncthreads();
}
constexpr int NWAVES = 8;
#ifndef MK_PER_PHASE
#define MK_PER_PHASE 0
#endif
constexpr int BATCH = 8, SEQ = 4096, D = 1024, DEPTH = 2, INW = 4096;
constexpr int M = BATCH * SEQ;
constexpr float NORM_EPS = 1e-6f;
constexpr int N_PHASES = 1 + 3 * DEPTH;

constexpr size_t MiB = 1u << 20;
constexpr size_t WS_CTL = 0, CTL_ZERO_BYTES = 1 * MiB;
constexpr size_t WS_SSQ = 1 * MiB;
constexpr size_t WS_KMEAN = 3 * MiB;
constexpr size_t WS_NPAST = 3 * MiB + 512 * 1024;
constexpr size_t WS_PARM = 3 * MiB + 640 * 1024;
constexpr int PARM_SW = 0, PARM_LAMV = DEPTH * 128;
constexpr size_t WS_ORDER = 3 * MiB + 576 * 1024;
constexpr size_t WS_NORMW = 3 * MiB + 768 * 1024;
constexpr size_t WS_WIN = 4 * MiB;
constexpr size_t WS_WOUT = 20 * MiB;
constexpr size_t WS_XN = 32 * MiB;
constexpr size_t WS_PROJ = 96 * MiB;
constexpr size_t WS_MIX = 352 * MiB;
constexpr size_t WS_OD = 416 * MiB;
constexpr size_t WS_END = 480 * MiB;
constexpr int CW_TMO = 0, CW_CODE = 1;
constexpr int CW_BAR = 4096;
constexpr int CW_CVTQ = 30720;
constexpr int CW_P3Q = 20480;
constexpr int CW_DONE = 24576;
constexpr int CW_ATTQ = 16384;

constexpr int RING_OFF = 0, RING_BYTES = 131072;
constexpr int LDSCTL_OFF = 147456, MISC_OFF = LDSCTL_OFF + 320;
constexpr int LDS_BYTES = 151552;
static_assert(MISC_OFF + 256 <= LDS_BYTES && attn_body::LDS_QB + 32768 <= LDSCTL_OFF && RING_BYTES <= LDSCTL_OFF && LDSCTL_OFF + 2048 + 192 <= LDS_BYTES, "LDS map");

struct Frame {
    LAS unsigned char* lds;
    volatile LAS unsigned* MISC;
    gu32* ctl;
    int wave;
    int vcu, G;
};
__device__ __forceinline__ int phase_tid(int wave) { int l; asm volatile("v_mbcnt_lo_u32_b32 %0, -1, 0\n\tv_mbcnt_hi_u32_b32 %0, -1, %0" : "=v"(l)); return (wave << 6) | l; }

__device__ __forceinline__ float wave_sum(float v) {
#pragma unroll
    for (int o = 1; o < 64; o <<= 1) v += __shfl_xor(v, o);
    return v;
}
template <bool PERMW>
__device__ __forceinline__ void p0_transpose_item(const float* W, int K, int N, bf16* WT, LAS float* scr, int item, int lane, const float* gk) {
    const int kblk = K / 16, nb = item / kblk, kb = item % kblk, k0 = 16 * kb, n0 = 128 * nb;
#pragma unroll
    for (int i = 0; i < 8; ++i) { const int kk = 2 * i + (lane >> 5); const float gg = gk ? gk[k0 + kk] : 1.0f;
        const f32x4 v = *(const GAS f32x4*)(W + (size_t)(k0 + kk) * N + n0 + 4 * (lane & 31)); *(LAS f32x4*)(scr + kk * 132 + 4 * (lane & 31)) = v * gg; }
    LDS_WAIT(); asm volatile("" ::: "memory");
#pragma unroll
    for (int h = 0; h < 2; ++h) { const int n = lane + 64 * h; const LAS float* s = scr + n;
        int r = n0 + n;
        if (PERMW) { const int pn = r >> 8, w = (r >> 6) & 3, bj = (r >> 5) & 1; r = (pn << 8) + (bj << 7) + (w << 5) + (r & 31); }
        v4u o0, o1;
        o0.x = pk2(s[0 * 132], s[1 * 132]); o0.y = pk2(s[2 * 132], s[3 * 132]); o0.z = pk2(s[4 * 132], s[5 * 132]); o0.w = pk2(s[6 * 132], s[7 * 132]);
        o1.x = pk2(s[8 * 132], s[9 * 132]); o1.y = pk2(s[10 * 132], s[11 * 132]); o1.z = pk2(s[12 * 132], s[13 * 132]); o1.w = pk2(s[14 * 132], s[15 * 132]);
        GAS v4u* dst = (GAS v4u*)(WT + (size_t)r * K + k0); dst[0] = o0; dst[1] = o1; }
    LDS_WAIT(); asm volatile("" ::: "memory");
}

struct Args { const float* in[13]; float* out; unsigned char* ws; int ph_lo, ph_hi; int nrep, pad; };

__device__ __forceinline__ void p0_prologue(Frame& FF, const Args& args) {
    struct { int lane, wave, vcu, G; LAS unsigned char* lds; } F;
    { const int t = phase_tid(FF.wave); F.lane = t & 63; F.wave = FF.wave; F.vcu = FF.vcu; F.G = FF.G; F.lds = FF.lds; }
    LAS float* scr = (LAS float*)(F.lds + RING_OFF + F.wave * 16384);
    const int gw = F.vcu * NWAVES + F.wave, NGW = F.G * NWAVES;
    if (gw == 0 || gw == NWAVES) {
        float w[DEPTH][4];
#pragma unroll
        for (int l = 0; l < DEPTH; ++l) { w[l][0] = args.in[3][l * 64 + F.lane]; w[l][1] = args.in[4][l * 64 + F.lane]; w[l][2] = args.in[5][l * 64 + F.lane]; w[l][3] = args.in[6][l * 64 + F.lane]; }
        if (gw == 0) {
            float* nw = (float*)(args.ws + WS_NORMW);
#pragma unroll
            for (int l = 0; l < DEPTH; ++l)
#pragma unroll
                for (int k = 0; k < 4; ++k) nw[(l * 4 + k) * 64 + F.lane] = w[l][k];
        } else {
            int* npast = (int*)(args.ws + WS_NPAST);
#pragma unroll
            for (int l = 0; l < DEPTH; ++l) {
                float mq = fabsf(w[l][0]), mk = fabsf(w[l][1]), dq = fabsf(w[l][2]), dk = fabsf(w[l][3]);
#pragma unroll
                for (int o = 1; o < 64; o <<= 1) { mq = fmaxf(mq, __shfl_xor(mq, o)); mk = fmaxf(mk, __shfl_xor(mk, o)); dq = fmaxf(dq, __shfl_xor(dq, o)); dk = fmaxf(dk, __shfl_xor(dk, o)); }
                if (F.lane < 16) {
                    const int s = F.lane; const bool moba = s < 8;
                    const float SB = 64.0f * pg8::C2Q * 1.02f * (moba ? mq * mk : dq * dk);
                    const float slope = moba ? exp2f(-(float)(s + 1)) : exp2f(-2.0f * (float)(((s - 8) >> 1) + 1));
                    const float a2 = 1.4426950408889634f * slope;
                    const float reach = (2.0f * SB + 40.0f) / a2;
                    float npf = ceilf(1.0f + (reach - 1.0f) * (1.0f / 64.0f));
                    npf = fminf(fmaxf(npf, 2.0f), 60.0f);
                    int np = (int)npf; np += (np & 1);
                    npast[l * 16 + s] = np;
                    ((float*)(args.ws + WS_NPAST + 1024))[l * 16 + s] = SB;
                }
            }
        }
    }
    if (gw == 2 * NWAVES) {
        float* pm = (float*)(args.ws + WS_PARM);
        float a1[DEPTH], b1[DEPTH], a2v[DEPTH], b2[DEPTH], s0[DEPTH], s1v[DEPTH];
#pragma unroll
        for (int l = 0; l < DEPTH; ++l) { a1[l] = args.in[7][l * 64 + F.lane]; b1[l] = args.in[8][l * 64 + F.lane]; a2v[l] = args.in[9][l * 64 + F.lane]; b2[l] = args.in[10][l * 64 + F.lane];
            s0[l] = args.in[11][l * 128 + F.lane]; s1v[l] = args.in[11][l * 128 + 64 + F.lane]; }
#pragma unroll
        for (int l = 0; l < DEPTH; ++l) {
            const float lam_init = (l == 0) ? 0.2f : 0.35550906759096926f;
            const float s1 = wave_sum(a1[l] * b1[l]), s2 = wave_sum(a2v[l] * b2[l]);
            if (F.lane == 0) pm[PARM_LAMV + l] = __expf(s1) - __expf(s2) + lam_init;
            pm[PARM_SW + l * 128 + F.lane] = s0[l] * (1.0f - lam_init); pm[PARM_SW + l * 128 + 64 + F.lane] = s1v[l] * (1.0f - lam_init); }
    }
    constexpr int I_IN = (D / 16) * (INW / 128), I_OUT = (D / 16) * (D / 128);
    bf16* win = (bf16*)(args.ws + WS_WIN);
#ifdef PROBE_P0_T
    unsigned tp0_ = (unsigned)__builtin_amdgcn_s_memrealtime();
#endif
    for (int it = gw; it < I_IN; it += NGW) p0_transpose_item<true>(args.in[2], D, INW, win, scr, it, F.lane, args.in[1]);
    for (int it = gw; it < I_OUT; it += NGW) p0_transpose_item<false>(args.in[12], D, D, (bf16*)(args.ws + WS_WOUT), scr, it, F.lane, nullptr);
#ifdef PROBE_P0_T
    { const unsigned tn_ = (unsigned)__builtin_amdgcn_s_memrealtime(); if (F.wave == 0 && F.lane == 0) ((volatile LAS unsigned*)(F.lds + MISC_OFF))[41] += tn_ - tp0_; tp0_ = tn_; }
#endif
    const float* x = args.in[0];
    bf16* XN = (bf16*)(args.ws + WS_XN); float* ssq = (float*)(args.ws + WS_SSQ);
    for (int m0 = gw; m0 < M; m0 += 4 * NGW) {
        f32x4 v[4][4]; float s[4];
#pragma unroll
        for (int k = 0; k < 4; ++k) { const int m = m0 + k * NGW; const GAS f32x4* xr = (const GAS f32x4*)(x + (size_t)(m < M ? m : gw) * D) + F.lane;
#pragma unroll
            for (int j = 0; j < 4; ++j) v[k][j] = xr[64 * j]; }
#pragma unroll
        for (int k = 0; k < 4; ++k) { float t = 0.f;
#pragma unroll
            for (int j = 0; j < 4; ++j) t += (v[k][j].x * v[k][j].x + v[k][j].y * v[k][j].y) + (v[k][j].z * v[k][j].z + v[k][j].w * v[k][j].w);
            s[k] = wave_sum(t); }
#pragma unroll
        for (int k = 0; k < 4; ++k) { const int m = m0 + k * NGW; if (m < M) {
            GAS unsigned long long* o8 = (GAS unsigned long long*)(XN + (size_t)m * D) + F.lane;
#pragma unroll
            for (int j = 0; j < 4; ++j) { const f32x4 y = v[k][j]; o8[64 * j] = (unsigned long long)pk2(y.x, y.y) | ((unsigned long long)pk2(y.z, y.w) << 32); }
            if (F.lane < 16) ssq[(size_t)m * 16 + F.lane] = (F.lane == 0) ? s[k] : 0.f; } }
    }
#ifdef PROBE_P0_T
    { const unsigned tn_ = (unsigned)__builtin_amdgcn_s_memrealtime(); if (F.wave == 0 && F.lane == 0) ((volatile LAS unsigned*)(F.lds + MISC_OFF))[42] += tn_ - tp0_; }
#endif
}

__device__ __forceinline__ void convert_rest(Frame& FF, const Args& args) {
    const int t = phase_tid(FF.wave), lane = t & 63;
    LAS float* scr = (LAS float*)(FF.lds + RING_OFF + FF.wave * 16384);
    constexpr int I_IN = (D / 16) * (INW / 128), I_OUT = (D / 16) * (D / 128), NREST = (DEPTH - 1) * I_IN + (DEPTH - 1) * I_OUT;
    bf16* win = (bf16*)(args.ws + WS_WIN); bf16* wout = (bf16*)(args.ws + WS_WOUT);
    gu32* head = FF.ctl + CW_CVTQ;
    for (int par = 0;; par ^= 1) {
        if (t == 0) FF.MISC[24 + par] = __hip_atomic_fetch_add(head, 1u, RLX_AGENT);
        __syncthreads();
        const int tk = (int)FF.MISC[24 + par];
        if (tk * NWAVES >= NREST) break;
        int r = tk * NWAVES + FF.wave;
        {
        if (r < (DEPTH - 1) * I_IN) { const int l = 1 + r / I_IN; r %= I_IN; p0_transpose_item<true>(args.in[2] + (size_t)l * D * INW, D, INW, win + (size_t)l * INW * D, scr, r, lane, args.in[1] + l * D); }
        else { r -= (DEPTH - 1) * I_IN;
        { const int l = 1 + r / I_OUT; r -= (l - 1) * I_OUT; p0_transpose_item<false>(args.in[12] + (size_t)l * D * D, D, D, wout + (size_t)l * D * D, scr, r, lane, nullptr); }
        }
        }
    }
}

constexpr int ATT_QLEN = 12 * 16;
__device__ __forceinline__ void attn_make_unit(const Args& args, int layer, int b, int idx, int comp, attn_body::UnitDesc& U, bool& isdiff) {
    const int qb = 15 - idx / 12, st = idx % 12;
    U.qb = qb; isdiff = st < 4;
    const int nps = ((const int*)(args.ws + WS_NPAST))[layer * 16 + (isdiff ? 8 + 2 * st : st - 4)];
    U.np = (4 * qb < nps) ? 4 * qb : nps;
    const float sb_ = ((const float*)(args.ws + WS_NPAST + 1024))[layer * 16 + (isdiff ? 8 + 2 * st : st - 4)];
    const attn_body::bf16* proj = (const attn_body::bf16*)(args.ws + WS_PROJ);
    const size_t TS = (size_t)M * 512, rb = (size_t)b * SEQ;
    if (!isdiff) {
        const int vh = st - 4;
        U.Q = proj + 0 * TS + rb * 512 + vh * 64; U.K = proj + 1 * TS + rb * 512 + vh * 64; U.V = proj + 2 * TS + rb * 512 + vh * 64; U.G = proj + 3 * TS + rb * 512 + vh * 64;
        U.O = (attn_body::bf16*)(args.ws + WS_MIX) + rb * 1024 + vh * 64;
        U.KM = (const float*)(args.ws + WS_KMEAN) + (size_t)(b * 8 + vh) * 16 * 2 * 64;
        U.a2 = 1.4426950408889634f * __builtin_amdgcn_exp2f(-(float)(vh + 1)); U.sbc = sb_ + 63.0f * U.a2;
        U.mode = 0; U.O1 = nullptr; U.SW = nullptr; U.lam = 0.f;
    } else {
        const int h = st, hc = 2 * h + comp;
        U.Q = proj + 4 * TS + rb * 512 + hc * 64; U.K = proj + 5 * TS + rb * 512 + hc * 64; U.V = proj + 6 * TS + rb * 512 + h * 128; U.G = proj + 7 * TS + rb * 512 + h * 128;
        U.O = (attn_body::bf16*)(args.ws + WS_MIX) + rb * 1024 + 512 + h * 128;
        U.KM = nullptr;
        U.a2 = 1.4426950408889634f * __builtin_amdgcn_exp2f(-2.0f * (float)(h + 1)); U.sbc = sb_ + 63.0f * U.a2;
        U.mode = 1 + comp; U.O1 = (float*)(args.ws + WS_OD) + (size_t)blockIdx.x * 32768;
        const float* pm = (const float*)(args.ws + WS_PARM); U.SW = pm + PARM_SW + layer * 128; U.lam = pm[PARM_LAMV + layer];
    }
}

__device__ __forceinline__ void attn_next_ptrs(const Args& args, int b, int idx, int comp, const attn_body::bf16*& pk, const attn_body::bf16*& pq) {
    const int qb = 15 - idx / 12, st = idx % 12;
    const attn_body::bf16* proj = (const attn_body::bf16*)(args.ws + WS_PROJ);
    const size_t TS = (size_t)M * 512, rb = (size_t)b * SEQ + (size_t)qb * 256;
    if (st >= 4) { const int vh = st - 4; pq = proj + 0 * TS + rb * 512 + vh * 64; pk = proj + 1 * TS + rb * 512 + vh * 64; }
    else { const int hc = 2 * st + comp; pq = proj + 4 * TS + rb * 512 + hc * 64; pk = proj + 5 * TS + rb * 512 + hc * 64; }
}

__device__ __forceinline__ void touch_xn_tiles(Frame& F, const Args& args) {
    const int t = phase_tid(F.wave), lane = t & 63;
    pg8::StaticOrder S; S.init(M, D, F.G, (int)blockIdx.x); pg8::Unit u;
    const attn_body::bf16* XN = (const attn_body::bf16*)(args.ws + WS_XN);
    const unsigned ldsb = (unsigned)(uintptr_t)(unsigned char*)(F.lds + RING_OFF) + (unsigned)F.wave * 16384u;
    for (int i = 0; S.next(i, u); ++i) {
        const attn_body::bf16* src = XN + (size_t)(u.pm * 256 + F.wave * 32 + (lane >> 5)) * 1024 + u.pn * 256 + (lane & 31) * 8;
#pragma unroll
        for (int p = 0; p < 16; ++p) attn_body::glds16(src + (size_t)(2 * p) * 1024, (unsigned)__builtin_amdgcn_readfirstlane(ldsb + (unsigned)p * 1024u));
        asm volatile("s_waitcnt vmcnt(0)" ::: "memory");
    }
}

__global__ void __launch_bounds__(NWAVES * 64, 2) mk_fwd(Args args) {
    extern __shared__ __attribute__((aligned(16))) unsigned char lds[];
    Frame F;
    F.lds = (LAS unsigned char*)lds;
    F.MISC = (volatile LAS unsigned*)(F.lds + MISC_OFF);
    F.wave = __builtin_amdgcn_readfirstlane((int)threadIdx.x >> 6);
    F.G = gridDim.x; { const int bx = blockIdx.x; F.vcu = (F.G % 8 == 0) ? (bx % 8) * (F.G / 8) + bx / 8 : bx; }
    unsigned char* ws = args.ws;
    F.ctl = (gu32*)(ws + WS_CTL);
    for (int u = threadIdx.x; u < (LDS_BYTES - LDSCTL_OFF) / 4; u += NWAVES * 64) ((LAS unsigned*)(F.lds + LDSCTL_OFF))[u] = 0u;
    __syncthreads();
    XcdBarrier bar; bar.bar = (unsigned*)(F.ctl + CW_BAR); bar.x = 0; bar.st = nullptr;
    if (!MK_PER_PHASE) bar = xcd_barrier_post((unsigned*)(F.ctl + CW_BAR), F.MISC + 8, (int)threadIdx.x);
#define GRID_BAR() do { if (MK_PER_PHASE) { if (phase_tid(F.wave) == 0) __hip_atomic_store(F.ctl + CW_TMO, 0xBADBA0u, RLX_AGENT); } else { xcd_barrier(bar, phase_tid(F.wave)); } } while (0)
#ifdef PROBE_TIME
    int n_stamp = 0;
#define STAMP() do { if (phase_tid(F.wave) == 0) F.MISC[20 + n_stamp] = (unsigned)__builtin_amdgcn_s_memrealtime(); ++n_stamp; } while (0)
#else
#define STAMP() do {} while (0)
#endif
    STAMP();
    const int lo = args.ph_lo, hi = args.ph_hi;
#define IN(k) (lo <= (k) && (k) < hi)
#define BOTH(k) (IN(k) && IN((k) + 1))

#ifndef DUP_PHASE
#define DUP_PHASE -1
#endif
#ifndef NO_P0
    if (IN(0)) { p0_prologue(F, args); if (DUP_PHASE == 0) { GRID_BAR(); p0_prologue(F, args); } if (BOTH(0)) GRID_BAR(); STAMP(); }
#endif

    for (int layer = 0; layer < DEPTH; ++layer) {
        const int pb = 1 + 3 * layer;
        for (int rep = 0; rep < ((DUP_PHASE == 1 && layer == 0) ? 2 : 1); ++rep)
        if (IN(pb)) {
#ifndef SKEW_P1_TICKS
#define SKEW_P1_TICKS 0
#endif
            if (SKEW_P1_TICKS > 0 && (F.vcu & 1)) { const unsigned long long t0_ = __builtin_amdgcn_s_memrealtime(); while (__builtin_amdgcn_s_memrealtime() - t0_ < (unsigned long long)SKEW_P1_TICKS) __builtin_amdgcn_s_sleep(16); }
            pg8::Gemm g{(const pg8::bf16_t*)(ws + WS_XN), (const pg8::bf16_t*)(ws + WS_WIN) + (size_t)layer * INW * D, M, INW, D};
            pg8::StaticOrder S; S.init(M, INW, F.G, (int)blockIdx.x);
            pg8::EpiProj E{(pg8::bf16_t*)(ws + WS_PROJ), (const float*)(ws + WS_SSQ), (const float*)(ws + WS_NORMW) + layer * 256, (float*)(ws + WS_KMEAN), args.nrep
#ifdef PROBE_EPI_T
                , F.MISC + 40
#endif
            };
#ifndef NO_PROJ
            pg8::gemm_phase<pg8::EpiProj, pg8::StaticOrder, PG8_ALIGN, PG8_SP2>(F.lds + RING_OFF, g, S, E, phase_tid(F.wave));
#endif
            if (BOTH(pb)) GRID_BAR(); STAMP();
        }
        for (int rep = 0; rep < ((DUP_PHASE == 2 && layer == 0) ? 2 : 1); ++rep)
        if (IN(pb + 1)) {
            attn_body::UnitDesc U;
#ifndef NO_ATTN
            const int atid = phase_tid(F.wave);
            const int myq = (int)(xb_xcc_id() & 7u);
            gu32* qh = F.ctl + CW_ATTQ + ((layer * 2 + rep) * 8) * 64;
            int par = 0;
            gu32* p3h = F.ctl + CW_P3Q + (layer * 8) * 64;
            gu32* donew = F.ctl + CW_DONE + layer * 128;
            const unsigned mybit = 1u << (4 * myq);
            const int last = (layer == DEPTH - 1);
            pg8::Gemm g3{(const pg8::bf16_t*)(ws + WS_MIX), (const pg8::bf16_t*)(ws + WS_WOUT) + (size_t)layer * D * D, M, D, D};
#ifdef PROBE_TIME
            pg8::EpiOut E3{(pg8::bf16_t*)(ws + WS_XN), args.out, (float*)(ws + WS_SSQ), last,
#ifdef PROBE_EPI_T
                F.MISC + 40,
#endif
                (const unsigned*)(ws + WS_NPAST + 4096), F.MISC + 20};
#else
            pg8::EpiOut E3{(pg8::bf16_t*)(ws + WS_XN), args.out, (float*)(ws + WS_SSQ), last};
#endif
            for (int qi = 0; qi < 8; ++qi) {
                const int q = (myq + qi) & 7;
                if (atid == 0) F.MISC[16 + par] = __hip_atomic_fetch_add(qh + q * 64, 1u, RLX_AGENT);
                __syncthreads();
                int pre = 0, pend = -1;
                for (;;) {
                    const int idx = (int)F.MISC[16 + par]; par ^= 1;
                    if (idx >= ATT_QLEN) break;
                    for (int comp = 0; comp < 2; ++comp) {
                        bool isdiff; attn_make_unit(args, layer, q, idx, comp, U, isdiff);
                        const bool lastpass = !isdiff || comp == 1;
                        U.qnext = lastpass ? (unsigned*)(qh + q * 64) : nullptr; U.qslot = (MISC_OFF - RING_OFF) + (16 + par) * 4;
                        U.pre = pre; U.pfK = nullptr; U.pfQ = nullptr; U.pfq2 = 0; pre = 0;
                        if (!lastpass) { attn_next_ptrs(args, q, idx, 1, U.pfK, U.pfQ); U.pfq2 = 1; pre = 1; }
                        U.pub = (pend >= 0) ? (unsigned*)(donew + pend) : nullptr; U.pubbit = mybit; pend = -1;
                        const int utid = phase_tid(F.wave);
                        if (isdiff) attn_body::attn_unit<8, 2>(U, (char*)lds + RING_OFF, utid);
                        else { attn_body::attn_unit<8, 1>(U, (char*)lds + RING_OFF, utid); pend = q * 16 + U.qb; break; }
                        if (lastpass) pend = q * 16 + U.qb;
                    }
                }
                asm volatile("s_waitcnt vmcnt(0)" ::: "memory");
                __syncthreads();
                if (pend >= 0 && atid == 0) (void)__hip_atomic_fetch_add(donew + pend, mybit, RLX_AGENT);
                for (;;) {
                    if (atid == 0) F.MISC[12] = __hip_atomic_fetch_add(p3h + q * 64, 1u, RLX_AGENT);
                    __syncthreads();
                    const int t3 = (int)F.MISC[12];
                    if (t3 >= 64) { __syncthreads(); break; }
                    const int qb3 = 15 - (t3 >> 2), pn3 = t3 & 3;
                    if (atid == 0) {
                        unsigned v = 0u, sp = 0u;
                        for (;;) { v = __hip_atomic_load(donew + q * 16 + qb3, RLX_AGENT); unsigned tot = 0u; for (int k = 0; k < 8; ++k) tot += (v >> (4 * k)) & 15u; if (tot >= 12u) break;
                            __builtin_amdgcn_s_sleep(8); if (++sp > (1u << 22)) break; }
                        if (((v >> (4 * myq)) & 15u) != 12u) __builtin_amdgcn_fence(__ATOMIC_ACQUIRE, "agent");
                    }
                    __syncthreads();
                    pg8::SingleOrder S3; S3.u.pm = q * 16 + qb3; S3.u.pn = pn3;
#ifndef NO_OUT
                    pg8::gemm_phase<pg8::EpiOut, pg8::SingleOrder, PG8_ALIGN, PG8_SP2>(F.lds + RING_OFF, g3, S3, E3, phase_tid(F.wave));
#endif
                }
            }
#endif
            if (layer == 0) convert_rest(F, args);
            if (BOTH(pb + 1) && layer + 1 < DEPTH) GRID_BAR(); STAMP();
        }
        if (IN(pb + 2)) { STAMP(); }
    }
#undef IN
#undef BOTH
}

extern "C" void kernel_launch(void* const* d_in, const int* in_sizes, int n_in, void* d_out, int out_size, void* d_ws, size_t ws_size, hipStream_t stream) {
    static int grid = 0;
    if (grid == 0) {
        if (n_in != 13 || in_sizes[0] != M * D || out_size != M * D || ws_size < WS_END) { fprintf(stderr, "kernel_launch: unexpected shapes (n_in %d in0 %d out %d ws %zu); nothing launched\n", n_in, n_in > 0 ? in_sizes[0] : -1, out_size, ws_size); grid = -1; return; }
        int dev = 0, cus = 0, per_cu = 0;
        if (hipGetDevice(&dev) != hipSuccess || hipDeviceGetAttribute(&cus, hipDeviceAttributeMultiprocessorCount, dev) != hipSuccess) { grid = -1; return; }
        if (hipFuncSetAttribute((const void*)mk_fwd, hipFuncAttributeMaxDynamicSharedMemorySize, LDS_BYTES) != hipSuccess) { fprintf(stderr, "kernel_launch: hipFuncSetAttribute failed\n"); grid = -1; return; }
        if (hipOccupancyMaxActiveBlocksPerMultiprocessor(&per_cu, (const void*)mk_fwd, NWAVES * 64, LDS_BYTES) != hipSuccess || per_cu < 1)
            fprintf(stderr, "kernel_launch: note: occupancy query reports %d workgroups per CU\n", per_cu);
        (void)hipGetLastError();
        grid = cus;
    }
    if (grid < 0) return;
    if (hipMemsetAsync((char*)d_ws + WS_CTL, 0, CTL_ZERO_BYTES, stream) != hipSuccess) return;
    Args a{};
    for (int i = 0; i < 13; ++i) a.in[i] = (const float*)d_in[i];
    a.out = (float*)d_out; a.ws = (unsigned char*)d_ws;
#ifdef PROBE_EPI2
    a.nrep = 2;
#else
    a.nrep = 1;
#endif
#if MK_PER_PHASE
    for (int p = 0; p < N_PHASES; ++p) { a.ph_lo = p; a.ph_hi = p + 1; hipLaunchKernelGGL(mk_fwd, dim3(grid), dim3(NWAVES * 64), LDS_BYTES, stream, a); }
#else
    a.ph_lo = 0; a.ph_hi = N_PHASES;
    hipLaunchKernelGGL(mk_fwd, dim3(grid), dim3(NWAVES * 64), LDS_BYTES, stream, a);
#endif
    const hipError_t le = hipPeekAtLastError();
    if (le != hipSuccess) fprintf(stderr, "kernel_launch: launch failed: %s (grid %d)\n", hipGetErrorName(le), grid);
}
```
